# Optimizing an MI355X kernel written in HIP

```python
import jax, jax.numpy as jnp
from jax import lax
import numpy as np

D_MODEL = 2048
BATCH = 2
SEQ = 8192
DEPTH = 2

CHUNK = 64
Q_BLOCK = 128

MLA_HEADS = 8
MLA_Q_RANK = 512
MLA_KV_RANK = 512
MLA_NOPE = 128
MLA_ROPE = 64
MLA_V = 128
ROPE_THETA = 10000.0

GLA_HEADS = 4
GLA_DK = 128
GLA_DV = 256
GLA_GATE_RANK = 16
GLA_GATE_NORM = 16.0

SGU_BLOCK = 128
SGU_DFF = 2 * D_MODEL
SGU_HALF = SGU_DFF // 2
SGU_GROUPS = 16
SGU_GROUP_DIM = SGU_HALF // SGU_GROUPS

N_EXPERTS = 16
N_GROUPS = 4
EXPERTS_PER_GROUP = N_EXPERTS // N_GROUPS
GROUP_SCORE_K = 2
TOP_K = 2
D_EXPERT = 512

ALPHA = (2.0 * DEPTH) ** 0.25
BETA = (8.0 * DEPTH) ** -0.25
EPS = 1e-6

N_EVEN = (DEPTH + 1) // 2
N_ODD = DEPTH // 2

EVEN_WIDTHS = (MLA_Q_RANK, MLA_KV_RANK, MLA_ROPE,
               GLA_HEADS * GLA_DK, GLA_HEADS * GLA_DK, GLA_HEADS * GLA_DV,
               GLA_GATE_RANK, GLA_HEADS * GLA_DV)
EVEN_SPLITS = tuple(int(c) for c in np.cumsum(EVEN_WIDTHS)[:-1])
EVEN_IN = int(sum(EVEN_WIDTHS))
MIX_WIDTH = MLA_HEADS * MLA_V + GLA_HEADS * GLA_DV

kernel_name = "hybrid_mla_gla_gmlp_groupmoe_deepnorm"


def layer_norm(x, g, b):
    xf = x.astype(jnp.float32)
    mu = jnp.mean(xf, -1, keepdims=True)
    var = jnp.mean(jnp.square(xf - mu), -1, keepdims=True)
    return ((xf - mu) * lax.rsqrt(var + EPS) * g + b).astype(x.dtype)


def rms_norm(x, g):
    xf = x.astype(jnp.float32)
    return (xf * lax.rsqrt(jnp.mean(jnp.square(xf), -1, keepdims=True) + EPS) * g).astype(x.dtype)


def rope_tables(positions):
    inv = 1.0 / (ROPE_THETA ** (jnp.arange(0, MLA_ROPE, 2, dtype=jnp.float32) / MLA_ROPE))
    ang = positions.astype(jnp.float32)[..., None] * inv
    return jnp.cos(ang), jnp.sin(ang)


def apply_rope(x, cos, sin):
    x1, x2 = jnp.split(x.astype(jnp.float32), 2, axis=-1)
    return jnp.concatenate([x1 * cos - x2 * sin, x2 * cos + x1 * sin], -1).astype(x.dtype)


def mla(c_q, c_kv, k_rope, g_q, g_kv, w_uq, w_ukv, cos, sin):
    B, S, _ = c_q.shape
    q = jnp.einsum('bsr,rhd->bshd', rms_norm(c_q, g_q), w_uq)
    q_nope = q[..., :MLA_NOPE]
    q_rot = apply_rope(q[..., MLA_NOPE:], cos[:, :, None], sin[:, :, None])
    kv = jnp.einsum('bsr,rhd->bshd', rms_norm(c_kv, g_kv), w_ukv)
    k_nope, v = kv[..., :MLA_NOPE], kv[..., MLA_NOPE:]
    k_rot = apply_rope(k_rope, cos, sin)
    scale = (MLA_NOPE + MLA_ROPE) ** -0.5
    n_blk = S // Q_BLOCK
    qn = q_nope.reshape(B, n_blk, Q_BLOCK, MLA_HEADS, MLA_NOPE).transpose(1, 0, 2, 3, 4)
    qr = q_rot.reshape(B, n_blk, Q_BLOCK, MLA_HEADS, MLA_ROPE).transpose(1, 0, 2, 3, 4)
    key_chunk = jnp.arange(S) // CHUNK

    def block(args):
        i, qn_b, qr_b = args
        s = (jnp.einsum('bqhd,bkhd->bhqk', qn_b, k_nope)
             + jnp.einsum('bqhd,bkd->bhqk', qr_b, k_rot)).astype(jnp.float32) * scale
        q_chunk = (i * Q_BLOCK + jnp.arange(Q_BLOCK)) // CHUNK
        mask = key_chunk[None, :] <= q_chunk[:, None]
        p = jax.nn.softmax(jnp.where(mask, s, -jnp.inf), axis=-1).astype(v.dtype)
        return jnp.einsum('bhqk,bkhd->bqhd', p, v)

    o = lax.map(block, (jnp.arange(n_blk), qn, qr))
    return o.transpose(1, 0, 2, 3, 4).reshape(B, S, MLA_HEADS * MLA_V)


def gla(q, k, v, gate_lr, g_out, w_gk2, b_gk2, g_norm):
    B, S, _ = q.shape
    nc = S // CHUNK
    log_g = jax.nn.log_sigmoid((gate_lr @ w_gk2 + b_gk2).astype(jnp.float32)) / GLA_GATE_NORM
    qh = q.astype(jnp.float32).reshape(B, nc, CHUNK, GLA_HEADS, GLA_DK) * GLA_DK ** -0.5
    kh = k.astype(jnp.float32).reshape(B, nc, CHUNK, GLA_HEADS, GLA_DK)
    vh = v.astype(jnp.float32).reshape(B, nc, CHUNK, GLA_HEADS, GLA_DV)
    cum = jnp.cumsum(log_g.reshape(B, nc, CHUNK, GLA_HEADS, GLA_DK), axis=2)
    cum_end = cum[:, :, -1]
    k_dec = kh * jnp.exp(cum_end[:, :, None] - cum)
    upd = jnp.einsum('bclhk,bclhv->bchkv', k_dec, vh)
    decay = jnp.exp(cum_end)

    def step(state, inp):
        d, u = inp
        state = d[..., None] * state + u
        return state, state

    init = jnp.zeros((B, GLA_HEADS, GLA_DK, GLA_DV), jnp.float32)
    _, states = lax.scan(step, init, (decay.transpose(1, 0, 2, 3), upd.transpose(1, 0, 2, 3, 4)))
    o = jnp.einsum('bclhk,cbhkv->bclhv', qh, states)
    o = o.reshape(B, S, GLA_HEADS, GLA_DV).astype(q.dtype)
    o = rms_norm(o, g_norm) * jax.nn.silu(g_out.reshape(B, S, GLA_HEADS, GLA_DV))
    return o.reshape(B, S, GLA_HEADS * GLA_DV)


def spatial_gating(h, ln_g, ln_b, w_s, b_s):
    B, S, _ = h.shape
    u, v = h[..., :SGU_HALF], h[..., SGU_HALF:]
    v = layer_norm(v, ln_g, ln_b)
    nb = S // SGU_BLOCK
    vb = v.reshape(B, nb, SGU_BLOCK, SGU_GROUPS, SGU_GROUP_DIM)
    pos_chunk = jnp.arange(SGU_BLOCK) // CHUNK
    mask = pos_chunk[None, :] <= pos_chunk[:, None]
    w = jnp.where(mask[None], w_s, jnp.zeros_like(w_s))
    mixed = jnp.einsum('gij,bnjgc->bnigc', w, vb) + b_s.T[None, None, :, :, None]
    return u * mixed.reshape(B, S, SGU_HALF)


def grouped_moe(x, router_w, router_b, w_gate, w_up, w_down):
    B, S, D = x.shape
    t = x.reshape(B * S, D)
    scores = jax.nn.sigmoid((t @ router_w).astype(jnp.float32))
    biased = scores + router_b.astype(jnp.float32)
    grp = biased.reshape(-1, N_GROUPS, EXPERTS_PER_GROUP)
    grp_score = lax.top_k(grp, GROUP_SCORE_K)[0].sum(-1)
    best = jnp.argmax(grp_score, axis=-1)
    in_grp = jnp.repeat(jax.nn.one_hot(best, N_GROUPS, dtype=jnp.bool_), EXPERTS_PER_GROUP, axis=-1)
    _, idx = lax.top_k(jnp.where(in_grp, biased, -jnp.inf), TOP_K)
    gate = jnp.take_along_axis(scores, idx, axis=1)
    gate = gate / jnp.sum(gate, -1, keepdims=True)
    combine = jnp.einsum('tk,tke->te', gate, jax.nn.one_hot(idx, N_EXPERTS, dtype=jnp.float32)).astype(t.dtype)
    y = jnp.zeros_like(t)
    for e in range(N_EXPERTS):
        h = jax.nn.silu(t @ w_gate[e]) * (t @ w_up[e])
        y = y + combine[:, e:e + 1] * (h @ w_down[e])
    return y.reshape(B, S, D)


def setup_inputs(seed: int = 0) -> dict:
    key = jax.random.key(seed)
    ks = iter(jax.random.split(key, 32))
    nrm = lambda shape, s: jax.random.normal(next(ks), shape, jnp.float32) * s
    gain = lambda shape: 1.0 + nrm(shape, 0.02)
    offset = jax.random.randint(next(ks), (BATCH, 1), 0, 1024, jnp.int32) * CHUNK
    return {
        "x": nrm((BATCH, SEQ, D_MODEL), 1.0),
        "positions": offset + jnp.arange(SEQ, dtype=jnp.int32)[None, :],
        "ev_w_in": nrm((N_EVEN, D_MODEL, EVEN_IN), D_MODEL ** -0.5),
        "ev_q_norm": gain((N_EVEN, MLA_Q_RANK)),
        "ev_kv_norm": gain((N_EVEN, MLA_KV_RANK)),
        "ev_w_uq": nrm((N_EVEN, MLA_Q_RANK, MLA_HEADS, MLA_NOPE + MLA_ROPE), MLA_Q_RANK ** -0.5),
        "ev_w_ukv": nrm((N_EVEN, MLA_KV_RANK, MLA_HEADS, MLA_NOPE + MLA_V), MLA_KV_RANK ** -0.5),
        "ev_w_gk2": nrm((N_EVEN, GLA_GATE_RANK, GLA_HEADS * GLA_DK), GLA_GATE_RANK ** -0.5),
        "ev_b_gk2": nrm((N_EVEN, GLA_HEADS * GLA_DK), 0.1),
        "ev_gla_norm": gain((N_EVEN, GLA_DV)),
        "ev_w_out": nrm((N_EVEN, MIX_WIDTH, D_MODEL), MIX_WIDTH ** -0.5 * BETA),
        "od_w_in": nrm((N_ODD, D_MODEL, SGU_DFF), D_MODEL ** -0.5),
        "od_sgu_ln_g": gain((N_ODD, SGU_HALF)),
        "od_sgu_ln_b": nrm((N_ODD, SGU_HALF), 0.02),
        "od_w_s": nrm((N_ODD, SGU_GROUPS, SGU_BLOCK, SGU_BLOCK), SGU_BLOCK ** -0.5),
        "od_b_s": gain((N_ODD, SGU_GROUPS, SGU_BLOCK)),
        "od_w_out": nrm((N_ODD, SGU_HALF, D_MODEL), SGU_HALF ** -0.5 * BETA),
        "ln_mix_g": gain((DEPTH, D_MODEL)),
        "ln_mix_b": nrm((DEPTH, D_MODEL), 0.02),
        "ln_ffn_g": gain((DEPTH, D_MODEL)),
        "ln_ffn_b": nrm((DEPTH, D_MODEL), 0.02),
        "router_w": nrm((D_MODEL, N_EXPERTS), D_MODEL ** -0.5),
        "router_b": nrm((N_EXPERTS,), 0.01),
        "moe_w_gate": nrm((DEPTH, N_EXPERTS, D_MODEL, D_EXPERT), D_MODEL ** -0.5),
        "moe_w_up": nrm((DEPTH, N_EXPERTS, D_MODEL, D_EXPERT), D_MODEL ** -0.5),
        "moe_w_down": nrm((DEPTH, N_EXPERTS, D_EXPERT, D_MODEL), D_EXPERT ** -0.5 * BETA),
    }


def reference(x, positions, ev_w_in, ev_q_norm, ev_kv_norm, ev_w_uq, ev_w_ukv, ev_w_gk2,
              ev_b_gk2, ev_gla_norm, ev_w_out, od_w_in, od_sgu_ln_g, od_sgu_ln_b, od_w_s,
              od_b_s, od_w_out, ln_mix_g, ln_mix_b, ln_ffn_g, ln_ffn_b, router_w, router_b,
              moe_w_gate, moe_w_up, moe_w_down):
    cos, sin = rope_tables(positions)
    for i in range(DEPTH):
        j = i // 2
        if i % 2 == 0:
            h = x @ ev_w_in[j]
            c_q, c_kv, k_r, g_q, g_k, g_v, g_lr, g_o = jnp.split(h, EVEN_SPLITS, axis=-1)
            o_a = mla(c_q, c_kv, k_r, ev_q_norm[j], ev_kv_norm[j], ev_w_uq[j], ev_w_ukv[j], cos, sin)
            o_b = gla(g_q, g_k, g_v, g_lr, g_o, ev_w_gk2[j], ev_b_gk2[j], ev_gla_norm[j])
            mix = jnp.concatenate([o_a, o_b], axis=-1) @ ev_w_out[j]
        else:
            h = jax.nn.gelu(x @ od_w_in[j])
            mix = spatial_gating(h, od_sgu_ln_g[j], od_sgu_ln_b[j], od_w_s[j], od_b_s[j]) @ od_w_out[j]
        x = layer_norm(ALPHA * x + mix, ln_mix_g[i], ln_mix_b[i])
        ffn = grouped_moe(x, router_w, router_b, moe_w_gate[i], moe_w_up[i], moe_w_down[i])
        x = layer_norm(ALPHA * x + ffn, ln_ffn_g[i], ln_ffn_b[i])
    return x
```

```cpp
#include <hip/hip_runtime.h>
#include <cstdio>
#include <cstdint>

#define GAS __attribute__((address_space(1)))
#define LAS __attribute__((address_space(3)))
typedef unsigned short bf16;
typedef short bf16x8 __attribute__((ext_vector_type(8)));
typedef short s16x4 __attribute__((ext_vector_type(4)));
typedef float f32x4 __attribute__((ext_vector_type(4)));
typedef float f32x2 __attribute__((ext_vector_type(2)));
typedef float f32x16 __attribute__((ext_vector_type(16)));
typedef unsigned u32x4 __attribute__((ext_vector_type(4)));
typedef unsigned u32x2 __attribute__((ext_vector_type(2)));
typedef __bf16 bf16x2_t __attribute__((ext_vector_type(2)));
typedef GAS unsigned gu32;

constexpr int T = 16384, D = 2048, SEQ = 8192, NB = 2;
constexpr int NH = 8, DQK = 192, DV = 128;
constexpr int GH = 4, GDK = 128, GDV = 256;
constexpr int NE = 16, DE = 512;
constexpr int HBW = 4096;
constexpr int COL_CQ = 0, COL_CKV = 512, COL_GQ = 1024, COL_GK = 1536, COL_GV = 2048, COL_GO = 3072;
constexpr float ALPHA = 1.41421356237309515f;
constexpr float EPS = 1e-6f;
constexpr float QSCALE = 0.07216878364870322f * 1.4426950408889634f;
constexpr int GRID = 256, NTHR = 512, NWAVES = 8;

constexpr size_t MiB = 1u << 20;
constexpr size_t WS_CTL = 0, CTL_ZERO_BYTES = 64 * 1024;
constexpr size_t WS_COS = 1 * MiB, WS_SIN = 3 * MiB, WS_DEC = 5 * MiB, WS_REC = 6 * MiB, WS_LIST = 7 * MiB, WS_WS = 8 * MiB, WS_WSUM = 8 * MiB + 512 * 1024;
constexpr size_t WS_RSQP = 9 * MiB, WS_RSKVP = 9 * MiB + 512 * 1024, WS_VSP = 10 * MiB, WS_VQP = 11 * MiB;
constexpr size_t WS_WIN0 = 16 * MiB, WS_WX0 = 32 * MiB, WS_WUQ = 33 * MiB, WS_WUK = 35 * MiB, WS_WUV = 36 * MiB, WS_WO0 = 38 * MiB, WS_WIN1 = 46 * MiB, WS_WO1 = 62 * MiB;
constexpr size_t WS_WGU0 = 70 * MiB, WS_WD0 = 134 * MiB;
constexpr size_t WS_XB = 166 * MiB;
constexpr size_t WS_X1 = 230 * MiB;
constexpr size_t WS_HB = 294 * MiB;
constexpr size_t WS_MIX = 438 * MiB;
constexpr size_t WS_QB = 502 * MiB, WS_KB = 550 * MiB;
constexpr size_t WS_END = 598 * MiB;
constexpr size_t WS_VTB = WS_XB, WS_HM = WS_XB, WS_UPD = WS_X1, WS_PRE = WS_HB, WS_U = WS_HB, WS_VT1 = WS_HB + 64 * MiB, WS_YS = WS_HB, WS_EXTRA = WS_MIX;
constexpr size_t WS_WGU1 = WS_QB, WS_WD1 = WS_QB + 64 * MiB;
constexpr int CW_BAR = 4096;
constexpr int CW_CNT = 8192;
constexpr size_t CTL_RSQ = 256 * 1024, CTL_RSKV = 320 * 1024, CTL_VSUM = 384 * 1024, CTL_VSQ = 448 * 1024;

constexpr int RING_BYTES = 131072;
constexpr int MISC_OFF = RING_BYTES;
constexpr int LDS_BYTES = 147456;
constexpr int MW_BAR = 0, MW_TP = 16, MW_CNT = 48, MW_LCNT = 64, MW_LBASE = 80, MW_REC = 128;

#define RLX_AGENT __ATOMIC_RELAXED, __HIP_MEMORY_SCOPE_AGENT
#define LDS_WAIT() asm volatile("s_waitcnt lgkmcnt(0)" ::: "memory")
__device__ __forceinline__ unsigned pk2(float lo, float hi) { f32x2 v = {lo, hi}; bf16x2_t b = __builtin_convertvector(v, bf16x2_t); return __builtin_bit_cast(unsigned, b); }
__device__ __forceinline__ float bf2f(unsigned short u) { return __builtin_bit_cast(float, (unsigned)u << 16); }
__device__ __forceinline__ float bflo(unsigned u) { return __builtin_bit_cast(float, u << 16); }
__device__ __forceinline__ float bfhi(unsigned u) { return __builtin_bit_cast(float, u & 0xffff0000u); }
__device__ __forceinline__ float fast_exp2(float x) { return __builtin_amdgcn_exp2f(x); }
__device__ __forceinline__ float fast_rcp(float x) { return __builtin_amdgcn_rcpf(x); }
__device__ __forceinline__ float sigmoidf_(float x) { return fast_rcp(1.0f + fast_exp2(-1.4426950408889634f * x)); }
__device__ __forceinline__ float gelu_tanh(float x) { const float z = x * (1.5957691216057308f + 0.07135481627f * x * x); return x * sigmoidf_(z); }
__device__ __forceinline__ float wave_sum(float v) {
#pragma unroll
    for (int o = 1; o < 64; o <<= 1) v += __shfl_xor(v, o);
    return v;
}
__device__ __forceinline__ int fresh_tid() { int t = threadIdx.x; asm volatile("" : "+v"(t)); return t; }
#define MFMA32(a, b, c) __builtin_amdgcn_mfma_f32_32x32x16_bf16((a), (b), (c), 0, 0, 0)

#define XB_TMO      128
#define XB_XCNT(j)  (256  + 64 * (j))
#define XB_XSUB(j)  (1280 + 64 * (j))
#define XB_XGEN(j)  (2304 + 64 * (j))
#define XB_TOP      3328
#define XB_TOPGEN   3392
#define XCD_BAR_WORDS 3456
#define XB_SPIN_CAP (1u << 22)
__device__ __forceinline__ unsigned xb_ld(unsigned* p)              { return __hip_atomic_load(p, __ATOMIC_RELAXED, __HIP_MEMORY_SCOPE_AGENT); }
__device__ __forceinline__ unsigned xb_add(unsigned* p, unsigned v) { return __hip_atomic_fetch_add(p, v, __ATOMIC_RELAXED, __HIP_MEMORY_SCOPE_AGENT); }
__device__ __forceinline__ unsigned xb_xcc_id() { return (unsigned)__builtin_amdgcn_s_getreg((3 << 11) | 20) & 0xFu; }
#define XB_SPIN(cond, bar) do { unsigned _sp = 0; while (cond) { __builtin_amdgcn_s_sleep(1); \
    if ((++_sp & 255u) == 0u) { if (xb_ld(&(bar)[XB_TMO])) break; if (_sp > XB_SPIN_CAP) { atomicAdd(&(bar)[XB_TMO], 1u); break; } } } } while (0)
struct XcdBarrier { unsigned* bar; unsigned x; volatile LAS unsigned* st; };
__device__ __forceinline__ XcdBarrier xcd_barrier_post(unsigned* bar, volatile LAS unsigned* st) {
    XcdBarrier b; b.bar = bar; b.x = xb_xcc_id(); b.st = st;
    if (threadIdx.x == 0) (void)xb_add(&bar[XB_XCNT(b.x)], 1u);
    return b;
}
__device__ __forceinline__ void xcd_barrier_complete(unsigned* bar, unsigned x, unsigned& nloc, unsigned& nx) {
    const unsigned G = gridDim.x * gridDim.y * gridDim.z;
    unsigned sum, cnt, mine, sp = 0u;
    for (;;) {
        sum = 0u; cnt = 0u; mine = 0u;
#pragma unroll
        for (unsigned j = 0; j < 16; ++j) { const unsigned c = xb_ld(&bar[XB_XCNT(j)]); sum += c; cnt += (c > 0u) ? 1u : 0u; mine = (j == x) ? c : mine; }
        if (sum == G) break;
        __builtin_amdgcn_s_sleep(1);
        if ((++sp & 255u) == 0u) { if (xb_ld(&bar[XB_TMO])) break; if (sp > XB_SPIN_CAP) { atomicAdd(&bar[XB_TMO], 1u); break; } }
    }
    nloc = mine > 0u ? mine : 1u; nx = cnt > 0u ? cnt : 1u;
}
__device__ __forceinline__ void xcd_barrier(const XcdBarrier& b) {
    asm volatile("s_waitcnt vmcnt(0)" ::: "memory");
    __syncthreads();
    if (threadIdx.x == 0) {
        unsigned* bar = b.bar;
        __builtin_amdgcn_s_waitcnt(0);
        unsigned nloc = b.st[0], nx = b.st[1];
        if (nloc == 0u) { xcd_barrier_complete(bar, b.x, nloc, nx); b.st[0] = nloc; b.st[1] = nx; }
        const unsigned old = xb_add(&bar[XB_XSUB(b.x)], 1u);
        const unsigned gen = old / nloc;
        if (old + 1u == (gen + 1u) * nloc) {
            __builtin_amdgcn_fence(__ATOMIC_RELEASE, "agent");
            asm volatile("s_waitcnt vmcnt(0)" ::: "memory");
            const unsigned og = xb_add(&bar[XB_TOP], 1u);
            const unsigned tg = og / nx;
            if (og + 1u == (tg + 1u) * nx) xb_add(&bar[XB_TOPGEN], 1u);
            else XB_SPIN(xb_ld(&bar[XB_TOPGEN]) == tg, bar);
            __builtin_amdgcn_fence(__ATOMIC_ACQUIRE, "agent");
            xb_add(&bar[XB_XGEN(b.x)], 1u);
            asm volatile("s_waitcnt vmcnt(0)" ::: "memory");
        } else {
            XB_SPIN(xb_ld(&bar[XB_XGEN(b.x)]) == gen, bar);
            __builtin_amdgcn_fence(__ATOMIC_ACQUIRE, "agent");
            asm volatile("s_waitcnt vmcnt(0)" ::: "memory");
        }
    }
    __syncthreads();
}

namespace pg8 {
constexpr int BM = 256, BK = 64, HALF = 128, HTB = HALF * BK * 2, STAGE_BYTES = 8 * HTB, NXCD = 8, WGM = 8;
__device__ __forceinline__ int lds_byte(int r, int c) { const int st = (r >> 4) * 2 + (c >> 5), rr = r & 15, cc = c & 31, ob = rr * 64 + cc * 2; return st * 1024 + (ob ^ (((ob >> 9) & 1) << 5)); }
__device__ __forceinline__ void stage_rc(int b, int& R, int& C) { const int st = b / 1024, sb = b % 1024, swz = sb ^ (((sb >> 9) & 1) << 5); R = (st >> 1) * 16 + swz / 64; C = (st & 1) * 32 + (swz % 64) / 2; }
__device__ __forceinline__ int perm32(int rho) { const int n = rho >> 4, i = rho & 15; return 8 * (i >> 2) + 4 * n + (i & 3); }

struct Unit { int pm, pn, aux, aux2; const char* a; const char* b; };

__device__ __forceinline__ void tile_of(int L, int nM, int nN, int& pm, int& pn) {
    const int nwg = nM * nN; int wgid = L;
    { const int q = nwg / NXCD, r = nwg % NXCD, xcd = wgid % NXCD, off = wgid / NXCD; wgid = (xcd < r ? xcd * (q + 1) : r * (q + 1) + (xcd - r) * q) + off; }
    const int nig = WGM * nN, gid = wgid / nig, fm = gid * WGM, gsz = (nM - fm) < WGM ? (nM - fm) : WGM;
    pm = fm + ((wgid % nig) % gsz); pn = (wgid % nig) / gsz;
}
struct PlainOrder {
    int nM, nN, nwg, G, c, ksplit; const char* A; const char* Bt; size_t a_tile, b_tile; size_t kslice_bytes;
    __device__ __forceinline__ void init(const void* A_, const void* Bt_, int M, int N, int lda, int ldb, int G_, int c_, int ksplit_ = 1, int Kslice = 0) {
        nM = M / BM; nN = N / BM; nwg = nM * nN; G = G_; c = c_; ksplit = ksplit_; A = (const char*)A_; Bt = (const char*)Bt_;
        a_tile = (size_t)BM * lda * 2; b_tile = (size_t)BM * ldb * 2; kslice_bytes = (size_t)Kslice * 2; }
    __device__ __forceinline__ bool next(int i, Unit& u) const {
        const long L = (long)i * G + c; if (L >= (long)nwg * ksplit) return false;
        const int ks = (int)(L / nwg), Lt = (int)(L % nwg);
        tile_of(Lt, nM, nN, u.pm, u.pn); u.aux = ks; u.aux2 = 0;
        u.a = A + (size_t)u.pm * a_tile + (size_t)ks * kslice_bytes; u.b = Bt + (size_t)u.pn * b_tile + (size_t)ks * kslice_bytes; return true; }
    __device__ __forceinline__ unsigned row_off(const Unit&, int) const { return 0u; }
};

template <class Epi, class Sched, bool GATHER>
__device__ __forceinline__ void gemm_phase(LAS unsigned char* lds, const int K, const int lda, const int ldb, const Sched& S, const Epi& E) {
    const int tid = fresh_tid(), wid = __builtin_amdgcn_readfirstlane(tid >> 6), lane = tid & 63, wr = wid >> 2, wc = wid & 3, fr = lane & 15, fq = lane >> 4;
    const int nt = K / BK;
    unsigned voffB[2], cvA[2][2], nvA[2][2]; int Rr[2], C2 = 0;
#pragma unroll
    for (int i = 0; i < 2; ++i) { int R, C; stage_rc(tid * 16 + i * 8192, R, C); const int Rb = Epi::PERM ? ((R & ~31) + perm32(R & 31)) : R;
        voffB[i] = (unsigned)(Rb * ldb + C) * 2u; Rr[i] = R; C2 = C * 2; }
    const size_t kstep = (size_t)(BK * 2);
    const size_t hstepB = (size_t)HALF * ldb * 2;
    const unsigned ldsw = (unsigned)wid * 1024u;
    const int aoff = lds_byte(wr * 64 + fr, fq * 8), boff = lds_byte(wc * 32 + fr, fq * 8);
#define PG8_SA(b, h) (((b) * 2 + (h)) * HTB)
#define PG8_SB(b, h) ((4 + (b) * 2 + (h)) * HTB)
#define PG8_STAGE(bufoff, gbase, voff) do { _Pragma("unroll") for (int _i = 0; _i < 2; ++_i) \
        __builtin_amdgcn_global_load_lds((const unsigned*)((const char*)(gbase) + (voff)[_i]), (LAS unsigned*)(lds + (bufoff) + ldsw + _i * 8192), 16, 0, 0); } while (0)
#define PG8_LDA(dst, b, h) do { _Pragma("unroll") for (int m = 0; m < 4; ++m) _Pragma("unroll") for (int k = 0; k < 2; ++k) dst[m][k] = *(const LAS bf16x8*)(lds + PG8_SA(b, h) + aoff + m * 2048 + k * 1024); } while (0)
#define PG8_LDB(dst, b, h) do { _Pragma("unroll") for (int n = 0; n < 2; ++n) _Pragma("unroll") for (int k = 0; k < 2; ++k) dst[n][k] = *(const LAS bf16x8*)(lds + PG8_SB(b, h) + boff + n * 2048 + k * 1024); } while (0)
#define PG8_MMA(ai, bj, At, Bt) do { __builtin_amdgcn_s_setprio(1); _Pragma("unroll") for (int m = 0; m < 4; ++m) _Pragma("unroll") for (int n = 0; n < 2; ++n) _Pragma("unroll") for (int k = 0; k < 2; ++k) \
        acc[ai][bj][m][n] = __builtin_amdgcn_mfma_f32_16x16x32_bf16(Bt[n][k], At[m][k], acc[ai][bj][m][n], 0, 0, 0); __builtin_amdgcn_s_setprio(0); } while (0)
#define PG8_WAIT_V(n) asm volatile("s_waitcnt vmcnt(" #n ")" ::: "memory")
#define PG8_WAIT_L(n) asm volatile("s_waitcnt lgkmcnt(" #n ")" ::: "memory")
#define PG8_BAR __builtin_amdgcn_s_barrier()
#define PG8_SCHED __builtin_amdgcn_sched_barrier(0)
#define PG8_OFFS(v, u) do { _Pragma("unroll") for (int _h = 0; _h < 2; ++_h) _Pragma("unroll") for (int _i = 0; _i < 2; ++_i) { const int _r = _h * HALF + Rr[_i]; \
        (v)[_h][_i] = GATHER ? (S.row_off((u), _r) + (unsigned)C2) : ((unsigned)(_r * lda) * 2u + (unsigned)C2); } } while (0)
    Unit cur, nxt; int ui = 0;
    if (!S.next(0, cur)) return;
    f32x4 acc[2][2][4][2];
#pragma unroll
    for (int a = 0; a < 2; ++a)
#pragma unroll
        for (int b = 0; b < 2; ++b)
#pragma unroll
            for (int m = 0; m < 4; ++m)
#pragma unroll
                for (int n = 0; n < 2; ++n) acc[a][b][m][n] = (f32x4){0.f, 0.f, 0.f, 0.f};
    bf16x8 At[4][2], B0[2][2], B1[2][2];
    const char* cA = cur.a; const char* cB = cur.b;
    PG8_OFFS(cvA, cur);
    if (GATHER) { asm volatile("s_waitcnt vmcnt(0)" ::: "memory"); asm volatile("" : "+v"(cvA[0][0]), "+v"(cvA[0][1]), "+v"(cvA[1][0]), "+v"(cvA[1][1])); }
    PG8_STAGE(PG8_SB(0, 0), cB, voffB); PG8_STAGE(PG8_SB(0, 1), cB + hstepB, voffB); PG8_STAGE(PG8_SA(0, 0), cA, cvA[0]); PG8_STAGE(PG8_SA(0, 1), cA, cvA[1]);
    if (wr == 1) PG8_BAR;
    PG8_WAIT_V(2); PG8_BAR;
    PG8_STAGE(PG8_SB(1, 0), cB + kstep, voffB); PG8_STAGE(PG8_SA(1, 0), cA + kstep, cvA[0]); PG8_STAGE(PG8_SB(1, 1), cB + hstepB + kstep, voffB);
    PG8_WAIT_V(6); PG8_BAR;
    for (;;) {
        const bool has_next = S.next(ui + 1, nxt);
        const char* nA = has_next ? nxt.a : cA; const char* nB = has_next ? nxt.b : cB;
        if (GATHER) { if (has_next) { PG8_OFFS(nvA, nxt); asm volatile("s_waitcnt vmcnt(0)" ::: "memory"); asm volatile("" : "+v"(nvA[0][0]), "+v"(nvA[0][1]), "+v"(nvA[1][0]), "+v"(nvA[1][1])); } else {
#pragma unroll
            for (int h = 0; h < 2; ++h)
#pragma unroll
                for (int i = 0; i < 2; ++i) nvA[h][i] = cvA[h][i]; } }
        else {
#pragma unroll
            for (int h = 0; h < 2; ++h)
#pragma unroll
                for (int i = 0; i < 2; ++i) nvA[h][i] = cvA[h][i]; }
        for (int t = 0; t < nt; t += 2) {
            const bool last = (t == nt - 2);
            const char* a1 = cA + (size_t)(t + 1) * kstep;
            const char* a2 = last ? nA : cA + (size_t)(t + 2) * kstep; const char* b2 = last ? nB : cB + (size_t)(t + 2) * kstep;
            const char* a3 = a2 + kstep; const char* b3 = b2 + kstep;
            unsigned o0[2], o1[2];
#pragma unroll
            for (int i = 0; i < 2; ++i) { o0[i] = last ? nvA[0][i] : cvA[0][i]; o1[i] = last ? nvA[1][i] : cvA[1][i]; }
            PG8_LDB(B0, 0, 0); PG8_LDB(B1, 0, 1); PG8_SCHED; PG8_LDA(At, 0, 0); PG8_STAGE(PG8_SA(1, 1), a1, cvA[1]);
            PG8_WAIT_V(8); PG8_WAIT_L(0); PG8_BAR; PG8_MMA(0, 0, At, B0); PG8_MMA(0, 1, At, B1); PG8_BAR; PG8_SCHED;
            PG8_LDA(At, 0, 1); PG8_STAGE(PG8_SB(0, 0), b2, voffB); PG8_STAGE(PG8_SB(0, 1), b2 + hstepB, voffB); PG8_STAGE(PG8_SA(0, 0), a2, o0);
            PG8_WAIT_V(8); PG8_WAIT_L(0); PG8_BAR; PG8_MMA(1, 0, At, B0); PG8_MMA(1, 1, At, B1); PG8_BAR; PG8_SCHED;
            PG8_LDB(B0, 1, 0); PG8_LDB(B1, 1, 1); PG8_SCHED; PG8_LDA(At, 1, 0); PG8_STAGE(PG8_SA(0, 1), a2, o1);
            PG8_WAIT_V(8); PG8_WAIT_L(0); PG8_BAR; PG8_MMA(0, 0, At, B0); PG8_MMA(0, 1, At, B1); PG8_BAR; PG8_SCHED;
            PG8_LDA(At, 1, 1); PG8_STAGE(PG8_SB(1, 0), b3, voffB); PG8_STAGE(PG8_SB(1, 1), b3 + hstepB, voffB); PG8_STAGE(PG8_SA(1, 0), a3, o0);
            PG8_WAIT_V(8); PG8_WAIT_L(0); PG8_BAR; PG8_MMA(1, 0, At, B0); PG8_MMA(1, 1, At, B1); PG8_BAR; PG8_SCHED;
        }
        if (wr == 0) PG8_BAR;
        E(acc, cur, wr, wc, fr, fq);
        if (!has_next) break;
#pragma unroll
        for (int a = 0; a < 2; ++a)
#pragma unroll
            for (int b = 0; b < 2; ++b)
#pragma unroll
                for (int m = 0; m < 4; ++m)
#pragma unroll
                    for (int n = 0; n < 2; ++n) acc[a][b][m][n] = (f32x4){0.f, 0.f, 0.f, 0.f};
        cur = nxt; cA = nA; cB = nB; ++ui;
#pragma unroll
        for (int h = 0; h < 2; ++h)
#pragma unroll
            for (int i = 0; i < 2; ++i) cvA[h][i] = nvA[h][i];
        if (wr == 1) PG8_BAR;
    }
    PG8_WAIT_V(0);
    PG8_BAR;
#undef PG8_SA
#undef PG8_SB
#undef PG8_STAGE
#undef PG8_LDA
#undef PG8_LDB
#undef PG8_MMA
#undef PG8_WAIT_V
#undef PG8_WAIT_L
#undef PG8_BAR
#undef PG8_SCHED
#undef PG8_OFFS
}
}

typedef f32x4 AccT[2][2][4][2];
__device__ __forceinline__ u32x4 pack8(const f32x4 v0, const f32x4 v1) { u32x4 w; w.x = pk2(v0[0], v0[1]); w.y = pk2(v0[2], v0[3]); w.z = pk2(v1[0], v1[1]); w.w = pk2(v1[2], v1[3]); return w; }

struct EpiIn0 {
    static constexpr bool PERM = true;
    bf16* HB; float* rsq; float* rskv;
    __device__ __forceinline__ void operator()(const AccT& acc, const pg8::Unit& u, int wr, int wc, int fr, int fq) const {
        const int row0 = u.pm * 256 + wr * 64 + fr, col0 = u.pn * 256 + wc * 32 + 8 * fq;
        float* rs = (u.pn < 2) ? rsq : rskv; const int slot = (u.pn & 1) * 4 + wc;
#pragma unroll
        for (int ai = 0; ai < 2; ++ai)
#pragma unroll
            for (int m = 0; m < 4; ++m) { const int row = row0 + ai * 128 + m * 16; bf16* rowp = HB + (size_t)row * HBW + col0; float ss = 0.f;
#pragma unroll
                for (int bj = 0; bj < 2; ++bj) { const f32x4 v0 = acc[ai][bj][m][0], v1 = acc[ai][bj][m][1];
                    ss += (v0[0] * v0[0] + v0[1] * v0[1]) + (v0[2] * v0[2] + v0[3] * v0[3]) + (v1[0] * v1[0] + v1[1] * v1[1]) + (v1[2] * v1[2] + v1[3] * v1[3]);
                    *(u32x4*)(rowp + bj * 128) = pack8(v0, v1); }
                if (u.pn < 4) { ss += __shfl_xor(ss, 16); ss += __shfl_xor(ss, 32); if (fq == 0) rs[(size_t)row * 8 + slot] = ss; } }
    }
};
__device__ __forceinline__ float rs_from_parts(const float* part, int row) {
    const f32x4 a = *(const f32x4*)(part + (size_t)row * 8), b = *(const f32x4*)(part + (size_t)row * 8 + 4);
    return rsqrtf((((a[0] + a[1]) + (a[2] + a[3])) + ((b[0] + b[1]) + (b[2] + b[3]))) * (1.0f / 512.0f) + EPS);
}
struct EpiExtra {
    static constexpr bool PERM = false;
    float* EX;
    __device__ __forceinline__ void operator()(const AccT& acc, const pg8::Unit& u, int wr, int wc, int fr, int fq) const {
        const int row0 = u.pm * 256 + wr * 64 + fr;
        if (wc > 2) return;
#pragma unroll
        for (int ai = 0; ai < 2; ++ai)
#pragma unroll
            for (int m = 0; m < 4; ++m) { float* rowp = EX + ((size_t)u.aux * T + row0 + ai * 128 + m * 16) * 128 + wc * 32 + 4 * fq;
                *(f32x4*)(rowp) = acc[ai][0][m][0];
                if (wc < 2) *(f32x4*)(rowp + 16) = acc[ai][0][m][1]; }
    }
};
struct EpiQ {
    static constexpr bool PERM = true;
    bf16* QB; const float* rsq; const float* cs; const float* sn;
    __device__ __forceinline__ void operator()(const AccT& acc, const pg8::Unit& u, int wr, int wc, int fr, int fq) const {
        const int row0 = u.pm * 256 + wr * 64 + fr;
#pragma unroll
        for (int ai = 0; ai < 2; ++ai)
#pragma unroll
            for (int m = 0; m < 4; ++m) { const int row = row0 + ai * 128 + m * 16; const int b = row >> 13, s = row & 8191;
                const float rs = rs_from_parts(rsq, row);
                if (u.pn < 4) {
#pragma unroll
                    for (int bj = 0; bj < 2; ++bj) { const int head = u.pn * 2 + bj; bf16* p = QB + ((size_t)(b * NH + head) * SEQ + s) * DQK + wc * 32 + 8 * fq;
                        *(u32x4*)p = pack8(acc[ai][bj][m][0] * rs, acc[ai][bj][m][1] * rs); }
                } else {
                    const int head = (u.pn - 4) * 4 + wc; bf16* p = QB + ((size_t)(b * NH + head) * SEQ + s) * DQK + 128 + 8 * fq;
                    const f32x4 c0 = *(const f32x4*)(cs + (size_t)row * 32 + 8 * fq), c1 = *(const f32x4*)(cs + (size_t)row * 32 + 8 * fq + 4);
                    const f32x4 s0 = *(const f32x4*)(sn + (size_t)row * 32 + 8 * fq), s1 = *(const f32x4*)(sn + (size_t)row * 32 + 8 * fq + 4);
                    const f32x4 a0 = acc[ai][0][m][0] * rs, a1 = acc[ai][0][m][1] * rs, b0 = acc[ai][1][m][0] * rs, b1 = acc[ai][1][m][1] * rs;
                    *(u32x4*)p = pack8(a0 * c0 - b0 * s0, a1 * c1 - b1 * s1);
                    *(u32x4*)(p + 32) = pack8(b0 * c0 + a0 * s0, b1 * c1 + a1 * s1); }
            }
    }
};
struct EpiK {
    static constexpr bool PERM = true;
    bf16* KB; const float* rskv;
    __device__ __forceinline__ void operator()(const AccT& acc, const pg8::Unit& u, int wr, int wc, int fr, int fq) const {
        const int row0 = u.pm * 256 + wr * 64 + fr;
#pragma unroll
        for (int ai = 0; ai < 2; ++ai)
#pragma unroll
            for (int m = 0; m < 4; ++m) { const int row = row0 + ai * 128 + m * 16; const int b = row >> 13, s = row & 8191;
                const float rs = rs_from_parts(rskv, row);
#pragma unroll
                for (int bj = 0; bj < 2; ++bj) { const int head = u.pn * 2 + bj; bf16* p = KB + ((size_t)(b * NH + head) * SEQ + s) * DQK + wc * 32 + 8 * fq;
                    *(u32x4*)p = pack8(acc[ai][bj][m][0] * rs, acc[ai][bj][m][1] * rs); } }
    }
};
struct EpiVt {
    static constexpr bool PERM = true;
    bf16* VTB; const float* rskv;
    __device__ __forceinline__ void operator()(const AccT& acc, const pg8::Unit& u, int wr, int wc, int fr, int fq) const {
        const int f0 = u.pm * 256 + wr * 64 + fr, tok0 = u.pn * 256 + wc * 32 + 8 * fq;
        f32x4 sc[2][2];
#pragma unroll
        for (int bj = 0; bj < 2; ++bj)
#pragma unroll
            for (int n = 0; n < 2; ++n)
#pragma unroll
                for (int j = 0; j < 4; ++j) sc[bj][n][j] = rs_from_parts(rskv, tok0 + bj * 128 + 4 * n + j);
#pragma unroll
        for (int ai = 0; ai < 2; ++ai)
#pragma unroll
            for (int m = 0; m < 4; ++m) { const int f = f0 + ai * 128 + m * 16; const int h = f >> 7, dv = f & 127;
#pragma unroll
                for (int bj = 0; bj < 2; ++bj) { const int tok = tok0 + bj * 128; const int b = tok >> 13, s = tok & 8191;
                    bf16* p = VTB + ((size_t)(b * NH + h) * DV + dv) * SEQ + s;
                    *(u32x4*)p = pack8(acc[ai][bj][m][0] * sc[bj][0], acc[ai][bj][m][1] * sc[bj][1]); } }
    }
};
template <bool RES_BF16> struct EpiPre {
    static constexpr bool PERM = true;
    bf16* PRE; const float* resf; const bf16* resb;
    __device__ __forceinline__ void operator()(const AccT& acc, const pg8::Unit& u, int wr, int wc, int fr, int fq) const {
        const int row0 = u.pm * 256 + wr * 64 + fr, col0 = u.pn * 256 + wc * 32 + 8 * fq;
#pragma unroll
        for (int ai = 0; ai < 2; ++ai) { f32x4 r0[4][2], r1[4][2]; u32x4 q[4][2];
#pragma unroll
            for (int m = 0; m < 4; ++m)
#pragma unroll
                for (int bj = 0; bj < 2; ++bj) { const size_t o = (size_t)(row0 + ai * 128 + m * 16) * D + col0 + bj * 128;
                    if (RES_BF16) q[m][bj] = *(const u32x4*)(resb + o); else { r0[m][bj] = *(const f32x4*)(resf + o); r1[m][bj] = *(const f32x4*)(resf + o + 4); } }
            asm volatile("" ::: "memory");
#pragma unroll
            for (int m = 0; m < 4; ++m)
#pragma unroll
                for (int bj = 0; bj < 2; ++bj) { const size_t o = (size_t)(row0 + ai * 128 + m * 16) * D + col0 + bj * 128;
                    if (RES_BF16) { const u32x4 t = q[m][bj]; r0[m][bj] = (f32x4){bflo(t.x), bfhi(t.x), bflo(t.y), bfhi(t.y)}; r1[m][bj] = (f32x4){bflo(t.z), bfhi(t.z), bflo(t.w), bfhi(t.w)}; }
                    *(u32x4*)(PRE + o) = pack8(r0[m][bj] * ALPHA + acc[ai][bj][m][0], r1[m][bj] * ALPHA + acc[ai][bj][m][1]); } }
    }
};
struct EpiMoeUp {
    static constexpr bool PERM = true;
    bf16* HM;
    __device__ __forceinline__ void operator()(const AccT& acc, const pg8::Unit& u, int wr, int wc, int fr, int fq) const {
        const int row0 = u.aux2 + wr * 64 + fr, col0 = u.pn * 128 + wc * 32 + 8 * fq;
#pragma unroll
        for (int ai = 0; ai < 2; ++ai)
#pragma unroll
            for (int m = 0; m < 4; ++m) { bf16* p = HM + (size_t)(row0 + ai * 128 + m * 16) * DE + col0; f32x4 h[2];
#pragma unroll
                for (int n = 0; n < 2; ++n)
#pragma unroll
                    for (int j = 0; j < 4; ++j) { const float g = acc[ai][0][m][n][j]; h[n][j] = g * sigmoidf_(g) * acc[ai][1][m][n][j]; }
                *(u32x4*)p = pack8(h[0], h[1]); }
    }
};
struct EpiMoeDown {
    static constexpr bool PERM = true;
    bf16* YS;
    __device__ __forceinline__ void operator()(const AccT& acc, const pg8::Unit& u, int wr, int wc, int fr, int fq) const {
        const int row0 = u.aux2 + wr * 64 + fr, col0 = u.pn * 256 + wc * 32 + 8 * fq;
#pragma unroll
        for (int ai = 0; ai < 2; ++ai)
#pragma unroll
            for (int m = 0; m < 4; ++m) { bf16* p = YS + (size_t)(row0 + ai * 128 + m * 16) * D + col0;
#pragma unroll
                for (int bj = 0; bj < 2; ++bj) *(u32x4*)(p + bj * 128) = pack8(acc[ai][bj][m][0], acc[ai][bj][m][1]); }
    }
};
struct EpiU {
    static constexpr bool PERM = true;
    bf16* U;
    __device__ __forceinline__ void operator()(const AccT& acc, const pg8::Unit& u, int wr, int wc, int fr, int fq) const {
        const int row0 = u.pm * 256 + wr * 64 + fr, col0 = u.pn * 256 + wc * 32 + 8 * fq;
#pragma unroll
        for (int ai = 0; ai < 2; ++ai)
#pragma unroll
            for (int m = 0; m < 4; ++m) { bf16* p = U + (size_t)(row0 + ai * 128 + m * 16) * D + col0;
#pragma unroll
                for (int bj = 0; bj < 2; ++bj) { f32x4 v0 = acc[ai][bj][m][0], v1 = acc[ai][bj][m][1];
#pragma unroll
                    for (int j = 0; j < 4; ++j) { v0[j] = gelu_tanh(v0[j]); v1[j] = gelu_tanh(v1[j]); }
                    *(u32x4*)(p + bj * 128) = pack8(v0, v1); } }
    }
};
struct EpiVT1 {
    static constexpr bool PERM = true;
    bf16* VT; float* vsum; float* vsq;
    __device__ __forceinline__ void operator()(const AccT& acc, const pg8::Unit& u, int wr, int wc, int fr, int fq) const {
        const int ch0 = u.pm * 256 + wr * 64 + fr, tok0 = u.pn * 256 + wc * 32 + 8 * fq;
        f32x4 s1[2][2], s2[2][2];
#pragma unroll
        for (int bj = 0; bj < 2; ++bj)
#pragma unroll
            for (int n = 0; n < 2; ++n) { s1[bj][n] = (f32x4){0.f, 0.f, 0.f, 0.f}; s2[bj][n] = (f32x4){0.f, 0.f, 0.f, 0.f}; }
#pragma unroll
        for (int ai = 0; ai < 2; ++ai)
#pragma unroll
            for (int m = 0; m < 4; ++m) { bf16* p = VT + (size_t)(ch0 + ai * 128 + m * 16) * T + tok0;
#pragma unroll
                for (int bj = 0; bj < 2; ++bj) { f32x4 v0 = acc[ai][bj][m][0], v1 = acc[ai][bj][m][1];
#pragma unroll
                    for (int j = 0; j < 4; ++j) { v0[j] = gelu_tanh(v0[j]); v1[j] = gelu_tanh(v1[j]); }
                    s1[bj][0] += v0; s1[bj][1] += v1; s2[bj][0] += v0 * v0; s2[bj][1] += v1 * v1;
                    *(u32x4*)(p + bj * 128) = pack8(v0, v1); } }
#pragma unroll
        for (int bj = 0; bj < 2; ++bj)
#pragma unroll
            for (int n = 0; n < 2; ++n)
#pragma unroll
                for (int j = 0; j < 4; ++j) { float a = s1[bj][n][j], b = s2[bj][n][j];
#pragma unroll
                    for (int o = 1; o < 16; o <<= 1) { a += __shfl_xor(a, o); b += __shfl_xor(b, o); }
                    if (fr == 0) { const int tok = tok0 + bj * 128 + 4 * n + j; vsum[(size_t)tok * 16 + u.pm * 2 + wr] = a; vsq[(size_t)tok * 16 + u.pm * 2 + wr] = b; } }
    }
};

struct Args { const void* in[26]; float* out; unsigned char* ws; };
struct Frame {
    LAS unsigned char* lds; volatile LAS unsigned* MISC;
    int vcu;
    unsigned char* ws; gu32* ctl;
};
#define PH_IDS() const int tid = fresh_tid(), lane = tid & 63, wave = __builtin_amdgcn_readfirstlane(tid >> 6); (void)lane; (void)wave
#define WSP(T_, off) ((T_*)(F.ws + (off)))

__device__ __forceinline__ void cvt_item(const float* src, int ldsrc, int scol0, int nvalid, bf16* dst, int ldk, int drow0, int k0, const float* ks, float sc, LAS float* scr, int lane) {
    const int n = lane & 31; float t[32];
    const float* sp = src + (size_t)(k0 + (lane >> 5)) * ldsrc + scol0 + n;
    if (n < nvalid) {
#pragma unroll
        for (int i = 0; i < 32; ++i) t[i] = __builtin_nontemporal_load(sp + (size_t)(2 * i) * ldsrc);
        if (ks) {
#pragma unroll
            for (int i = 0; i < 32; ++i) t[i] *= ks[k0 + 2 * i + (lane >> 5)];
        }
    } else {
#pragma unroll
        for (int i = 0; i < 32; ++i) t[i] = 0.f;
    }
#pragma unroll
    for (int i = 0; i < 32; ++i) scr[(2 * i + (lane >> 5)) * 33 + n] = t[i] * sc;
    LDS_WAIT(); asm volatile("" ::: "memory");
    const int c = lane & 7;
#pragma unroll
    for (int j = 0; j < 4; ++j) { const int nn = (lane >> 3) + 8 * j; const LAS float* s = scr + (8 * c) * 33 + nn;
        u32x4 o; o.x = pk2(s[0 * 33], s[1 * 33]); o.y = pk2(s[2 * 33], s[3 * 33]); o.z = pk2(s[4 * 33], s[5 * 33]); o.w = pk2(s[6 * 33], s[7 * 33]);
        *(u32x4*)(dst + (size_t)(drow0 + nn) * ldk + k0 + 8 * c) = o; }
    LDS_WAIT(); asm volatile("" ::: "memory");
}
constexpr int MOE_CVT_SPLIT = 19660;
__device__ __forceinline__ void cvt_moe_layer(Frame& F, const float* wg, const float* wu, const float* wd, bf16* WGU, bf16* WD, int first_blk = 0, int it_lo = 0, int it_hi = 16 * 32 * 32 + 16 * 8 * 64) {
    PH_IDS();
    LAS float* scr = (LAS float*)(F.lds + wave * 16384);
    constexpr int I_GU = 16 * 32 * 32, I_D = 16 * 8 * 64;
    const int gw = ((first_blk ? (int)blockIdx.x - first_blk : F.vcu)) * NWAVES + wave, ngw = (GRID - first_blk) * NWAVES;
    for (int it = it_lo + gw; it < it_hi; it += ngw) {
        if (it < I_GU) { const int e = it >> 10, r = it & 1023, kb = r >> 5, nb = r & 31, p0 = 32 * nb, pn = p0 >> 8, sel = (p0 >> 7) & 1, c = p0 & 127;
            cvt_item((sel ? wu : wg) + (size_t)e * D * DE, DE, 128 * pn + c, 32, WGU + (size_t)e * 1024 * D, D, p0, 64 * kb, nullptr, 1.f, scr, lane); }
        else { const int q = it - I_GU, e = q >> 9, r = q & 511, kb = r >> 6, nb = r & 63;
            cvt_item(wd + (size_t)e * DE * D, D, 32 * nb, 32, WD + (size_t)e * D * DE, DE, 32 * nb, 64 * kb, nullptr, 1.f, scr, lane); }
    }
}
struct BgItem { const float* sp; bf16* dp; int ldsrc, ldk; };
struct BgCtx { const float* wg; const float* wu; const float* wd; const float* wo0; const float* win1; const float* wo1; unsigned char* ws; int it, q, ld8; const float* sp; };
constexpr int BG_MOE_ITEMS = 16 * 32 * 32 + 16 * 8 * 64, BG_ITEMS = BG_MOE_ITEMS + 32 * 64 + 32 * 128 + 32 * 64;
__device__ __forceinline__ BgItem bg_item(int it, const BgCtx& G, int lane) {
    constexpr int I_GU = 16 * 32 * 32; BgItem b; const float* src; bf16* dst; int scol0, drow0, k0;
    const float* wg = G.wg; const float* wu = G.wu; const float* wd = G.wd; bf16* WGU = (bf16*)(G.ws + WS_WGU0); bf16* WD = (bf16*)(G.ws + WS_WD0);
    if (it >= BG_MOE_ITEMS) { int r = it - BG_MOE_ITEMS;
        if (r < 2048) { const int kb = r >> 6, nb = r & 63; src = G.wo0; b.ldsrc = D; scol0 = 32 * nb; dst = (bf16*)(G.ws + WS_WO0); b.ldk = D; drow0 = 32 * nb; k0 = 64 * kb; }
        else if ((r -= 2048) < 4096) { const int kb = r >> 7, nb = r & 127; src = G.win1; b.ldsrc = 4096; scol0 = 32 * nb; dst = (bf16*)(G.ws + WS_WIN1); b.ldk = D; drow0 = 32 * nb; k0 = 64 * kb; }
        else { r -= 4096; const int kb = r >> 6, nb = r & 63; src = G.wo1; b.ldsrc = D; scol0 = 32 * nb; dst = (bf16*)(G.ws + WS_WO1); b.ldk = D; drow0 = 32 * nb; k0 = 64 * kb; } }
    else
    if (it < I_GU) { const int e = it >> 10, r = it & 1023, kb = r >> 5, nb = r & 31, p0 = 32 * nb, pn = p0 >> 8, sel = (p0 >> 7) & 1, c = p0 & 127;
        src = (sel ? wu : wg) + (size_t)e * D * DE; b.ldsrc = DE; scol0 = 128 * pn + c; dst = WGU + (size_t)e * 1024 * D; b.ldk = D; drow0 = p0; k0 = 64 * kb; }
    else { const int q = it - I_GU, e = q >> 9, r = q & 511, kb = r >> 6, nb = r & 63;
        src = wd + (size_t)e * DE * D; b.ldsrc = D; scol0 = 32 * nb; dst = WD + (size_t)e * D * DE; b.ldk = DE; drow0 = 32 * nb; k0 = 64 * kb; }
    b.sp = src + (size_t)(k0 + (lane >> 3)) * b.ldsrc + scol0 + 4 * (lane & 7); b.dp = dst + (size_t)drow0 * b.ldk + k0;
    return b;
}
constexpr int BG_P = 72, BG_SCR = 32 * BG_P * 2;
#define BG_PUT(t_, scr_, lane_, q_) do { LAS unsigned short* w_ = (scr_) + (4 * ((lane_) & 7)) * BG_P + 8 * (q_) + ((lane_) >> 3); const unsigned a_ = pk2(t_[0], t_[1]), b_ = pk2(t_[2], t_[3]); \
        w_[0] = (unsigned short)a_; w_[BG_P] = (unsigned short)(a_ >> 16); w_[2 * BG_P] = (unsigned short)b_; w_[3 * BG_P] = (unsigned short)(b_ >> 16); } while (0)
#define BG_STORE(b_, scr_, lane_) do { \
        LDS_WAIT(); asm volatile("" ::: "memory"); \
        _Pragma("unroll") for (int j_ = 0; j_ < 4; ++j_) { const int nn_ = ((lane_) >> 3) + 8 * j_; \
            *(u32x4*)((b_).dp + (size_t)nn_ * (b_).ldk + 8 * ((lane_) & 7)) = *(const LAS u32x4*)((scr_) + nn_ * BG_P + 8 * ((lane_) & 7)); } \
        LDS_WAIT(); asm volatile("" ::: "memory"); } while (0)
__device__ const double INV_FREQ[32] = {
    1.0, 0.7498942093324559, 0.5623413251903491, 0.4216965034285822, 0.31622776601683794, 0.23713737056616552, 0.1778279410038923, 0.1333521432163324,
    0.1, 0.07498942093324558, 0.05623413251903491, 0.04216965034285822, 0.03162277660168379, 0.023713737056616554, 0.01778279410038923, 0.01333521432163324,
    0.01, 0.007498942093324558, 0.005623413251903491, 0.004216965034285823, 0.0031622776601683794, 0.0023713737056616554, 0.0017782794100389228, 0.001333521432163324,
    0.001, 0.0007498942093324559, 0.0005623413251903491, 0.00042169650342858224, 0.00031622776601683794, 0.00023713737056616554, 0.00017782794100389227, 0.0001333521432163324};
__device__ __forceinline__ void sincos_d(double a, float& s, float& c) {
    const double q = __builtin_rint(a * 0.63661977236758134308);
    double r = __builtin_fma(-q, 1.57079632679489655800e+00, a); r = __builtin_fma(-q, 6.12323399573676603587e-17, r);
    const double r2 = r * r;
    double sp = -2.50521083854417187751e-08; sp = sp * r2 + 2.75573192239858906526e-06; sp = sp * r2 - 1.98412698412698412698e-04; sp = sp * r2 + 8.33333333333333333333e-03; sp = sp * r2 - 1.66666666666666666667e-01;
    const double sn = r + r * r2 * sp;
    double cp = 2.08767569878680989792e-09; cp = cp * r2 - 2.75573192239858906526e-07; cp = cp * r2 + 2.48015873015873015873e-05; cp = cp * r2 - 1.38888888888888888889e-03; cp = cp * r2 + 4.16666666666666666667e-02; cp = cp * r2 - 0.5;
    const double cn = 1.0 + r2 * cp;
    const int qi = (int)((long long)q & 3);
    const double ss = (qi == 0) ? sn : (qi == 1) ? cn : (qi == 2) ? -sn : -cn;
    const double cc = (qi == 0) ? cn : (qi == 1) ? -sn : (qi == 2) ? -cn : sn;
    s = (float)ss; c = (float)cc;
}
__device__ __forceinline__ void p0_prologue(Frame& F, const Args& A) {
    PH_IDS();
    LAS float* scr = (LAS float*)(F.lds + wave * 16384);
    const int gw = F.vcu * NWAVES + wave, NGW = GRID * NWAVES;
    const float* ev_w_in = (const float*)A.in[2]; const float* ev_q_norm = (const float*)A.in[3]; const float* ev_kv_norm = (const float*)A.in[4];
    const float* ev_w_uq = (const float*)A.in[5]; const float* ev_w_ukv = (const float*)A.in[6]; const float* ev_w_out = (const float*)A.in[10];
    const float* od_w_in = (const float*)A.in[11]; const float* od_w_out = (const float*)A.in[16];
    constexpr int I_IN0 = 32 * 128, I_X0 = 32 * 8, I_UQ = 8 * 48, I_UK = 8 * 32, I_UV = 8 * 32, I_O0 = 32 * 64, I_IN1 = 32 * 128, I_O1 = 32 * 64;
    constexpr int NIT = I_IN0 + I_X0 + I_UQ + I_UK + I_UV + I_O0 + I_IN1 + I_O1;
    for (int it = gw; it < NIT - (I_O0 + I_IN1 + I_O1); it += NGW) {
        int r = it; const float* src; int ldsrc, scol0, nvalid = 32, ldk, drow0, k0; bf16* dst; const float* ks = nullptr; float sc = 1.f;
        if (r < I_IN0) { const int kb = r >> 7, nb = r & 127, p0 = 32 * nb; src = ev_w_in; ldsrc = 4176; scol0 = p0 < 1024 ? p0 : (p0 < 3072 ? p0 + 64 : p0 + 80); dst = WSP(bf16, WS_WIN0); ldk = D; drow0 = p0; k0 = 64 * kb; }
        else if ((r -= I_IN0) < I_X0) { const int kb = r >> 3, nb = r & 7, p0 = 32 * nb; src = ev_w_in; ldsrc = 4176; scol0 = nb < 2 ? 1024 + p0 : 3136; nvalid = nb < 2 ? 32 : (nb == 2 ? 16 : 0); dst = WSP(bf16, WS_WX0); ldk = D; drow0 = p0; k0 = 64 * kb; }
        else if ((r -= I_X0) < I_UQ) { const int kb = r / 48, nb = r % 48, p0 = 32 * nb; src = ev_w_uq; ldsrc = 1536; ks = ev_q_norm; sc = QSCALE;
            if (p0 < 1024) scol0 = (p0 >> 7) * 192 + (p0 & 127); else { const int q = p0 - 1024, tt = q >> 8, bj = (q >> 7) & 1, hl = (q >> 5) & 3; scol0 = (4 * tt + hl) * 192 + 128 + 32 * bj; }
            dst = WSP(bf16, WS_WUQ); ldk = 512; drow0 = p0; k0 = 64 * kb; }
        else if ((r -= I_UQ) < I_UK) { const int kb = r >> 5, nb = r & 31, p0 = 32 * nb; src = ev_w_ukv; ldsrc = 2048; ks = ev_kv_norm; scol0 = (p0 >> 7) * 256 + (p0 & 127); dst = WSP(bf16, WS_WUK); ldk = 512; drow0 = p0; k0 = 64 * kb; }
        else if ((r -= I_UK) < I_UV) { const int kb = r >> 5, nb = r & 31, p0 = 32 * nb; src = ev_w_ukv; ldsrc = 2048; ks = ev_kv_norm; scol0 = (p0 >> 7) * 256 + 128 + (p0 & 127); dst = WSP(bf16, WS_WUV); ldk = 512; drow0 = p0; k0 = 64 * kb; }
        else if ((r -= I_UV) < I_O0) { const int kb = r >> 6, nb = r & 63; src = ev_w_out; ldsrc = D; scol0 = 32 * nb; dst = WSP(bf16, WS_WO0); ldk = D; drow0 = 32 * nb; k0 = 64 * kb; }
        else if ((r -= I_O0) < I_IN1) { const int kb = r >> 7, nb = r & 127; src = od_w_in; ldsrc = 4096; scol0 = 32 * nb; dst = WSP(bf16, WS_WIN1); ldk = D; drow0 = 32 * nb; k0 = 64 * kb; }
        else { r -= I_IN1; const int kb = r >> 6, nb = r & 63; src = od_w_out; ldsrc = D; scol0 = 32 * nb; dst = WSP(bf16, WS_WO1); ldk = D; drow0 = 32 * nb; k0 = 64 * kb; }
        cvt_item(src, ldsrc, scol0, nvalid, dst, ldk, drow0, k0, ks, sc, scr, lane);
    }
    { const float* x = (const float*)A.in[0]; bf16* XB = WSP(bf16, WS_XB);
      for (size_t i = (size_t)blockIdx.x * NTHR + tid; i < (size_t)T * D / 8; i += (size_t)GRID * NTHR) {
          const f32x4 a = __builtin_nontemporal_load((const f32x4*)(x + i * 8)), b = __builtin_nontemporal_load((const f32x4*)(x + i * 8 + 4)); *(u32x4*)(XB + i * 8) = pack8(a, b); } }
    { const int* pos = (const int*)A.in[1]; float* cs = WSP(float, WS_COS); float* sn = WSP(float, WS_SIN);
      for (int i = blockIdx.x * NTHR + tid; i < T * 32; i += GRID * NTHR) { float s, c; sincos_d((double)pos[i >> 5] * INV_FREQ[i & 31], s, c); cs[i] = c; sn[i] = s; } }
    { const float* w_s = (const float*)A.in[14]; bf16* WS_ = WSP(bf16, WS_WS); float* wsum = WSP(float, WS_WSUM);
      for (int i = blockIdx.x * NTHR + tid; i < 16 * 128 * 128; i += GRID * NTHR) { const int ii = (i >> 7) & 127, j = i & 127; const float v = ((j >> 6) <= (ii >> 6)) ? w_s[i] : 0.f; WS_[i] = (bf16)(pk2(v, 0.f) & 0xffffu); }
      for (int i = blockIdx.x * NTHR + tid; i < 16 * 128; i += GRID * NTHR) { const int ii = i & 127; float s = 0.f; const int jn = (ii >> 6) ? 128 : 64; for (int j = 0; j < jn; ++j) s += w_s[(size_t)i * 128 + j]; wsum[i] = s; } }
}

__device__ __forceinline__ void krot_phase(Frame& F) {
    const float* EX = WSP(float, WS_EXTRA); const float* cs = WSP(float, WS_COS); const float* sn = WSP(float, WS_SIN); bf16* KB = WSP(bf16, WS_KB);
    PH_IDS();
    for (int idx = blockIdx.x * NTHR + tid; idx < T * 32; idx += GRID * NTHR) {
        const int t = idx >> 5, i = idx & 31; float x1 = 0.f, x2 = 0.f;
#pragma unroll
        for (int kq = 0; kq < 4; ++kq) { x1 += EX[((size_t)kq * T + t) * 128 + i]; x2 += EX[((size_t)kq * T + t) * 128 + 32 + i]; }
        const float c = cs[idx], s = sn[idx];
        const unsigned short o1 = (unsigned short)(pk2(x1 * c - x2 * s, 0.f) & 0xffffu), o2 = (unsigned short)(pk2(x2 * c + x1 * s, 0.f) & 0xffffu);
        const int b = t >> 13, sq = t & 8191;
#pragma unroll
        for (int h = 0; h < NH; ++h) { bf16* p = KB + ((size_t)(b * NH + h) * SEQ + sq) * DQK + 128 + i; p[0] = o1; p[32] = o2; }
    }
}

__device__ __forceinline__ void gla_upd_phase(Frame& F, const float* w_gk2, const float* b_gk2) {
    const bf16* HB = WSP(bf16, WS_HB); const float* EX = WSP(float, WS_EXTRA); bf16* UPD = WSP(bf16, WS_UPD); float* DEC = WSP(float, WS_DEC);
    LAS float* glr = (LAS float*)(F.lds);
    LAS float* tot = (LAS float*)(F.lds + 4096);
    LAS bf16* kdT = (LAS bf16*)(F.lds + 8192);
    LAS bf16* vT = (LAS bf16*)(F.lds + 26624);
    LAS bf16* ot = (LAS bf16*)(F.lds + 63488);
    PH_IDS(); const int w = wave, r = lane & 31, hh = lane >> 5;
    const int h = F.vcu & 3;
    const int dk = tid & 127, pg = tid >> 7, dvv = tid & 255, hf = tid >> 8;
    float wv[16];
#pragma unroll
    for (int rr = 0; rr < 16; ++rr) wv[rr] = w_gk2[rr * 512 + h * 128 + dk];
    const float bias = b_gk2[h * 128 + dk];
    float exr[8]; unsigned short vraw[32], kraw[16];
#define G1_LOAD(u_) do { const int bc_ = (u_) >> 2, t0_ = (bc_ >> 7) * SEQ + (bc_ & 127) * 64; \
        _Pragma("unroll") for (int k = 0; k < 2; ++k) { const int idx = tid + 512 * k, pos = idx >> 4, rr = idx & 15; \
            _Pragma("unroll") for (int kq = 0; kq < 4; ++kq) exr[4 * k + kq] = EX[((size_t)kq * T + t0_ + pos) * 128 + 64 + rr]; } \
        _Pragma("unroll") for (int p = 0; p < 32; ++p) vraw[p] = HB[(size_t)(t0_ + hf * 32 + p) * HBW + COL_GV + h * 256 + dvv]; \
        _Pragma("unroll") for (int p = 0; p < 16; ++p) kraw[p] = HB[(size_t)(t0_ + pg * 16 + p) * HBW + COL_GK + h * 128 + dk]; } while (0)
    if (F.vcu < 1024) G1_LOAD(F.vcu);
    for (int u = F.vcu; u < 1024; u += GRID) {
#pragma unroll
        for (int k = 0; k < 2; ++k) glr[tid + 512 * k] = (exr[4 * k] + exr[4 * k + 1]) + (exr[4 * k + 2] + exr[4 * k + 3]);
#pragma unroll
        for (int q = 0; q < 4; ++q) { u32x4 o; o.x = (unsigned)vraw[8 * q] | ((unsigned)vraw[8 * q + 1] << 16); o.y = (unsigned)vraw[8 * q + 2] | ((unsigned)vraw[8 * q + 3] << 16);
            o.z = (unsigned)vraw[8 * q + 4] | ((unsigned)vraw[8 * q + 5] << 16); o.w = (unsigned)vraw[8 * q + 6] | ((unsigned)vraw[8 * q + 7] << 16);
            *(LAS u32x4*)(vT + dvv * 72 + hf * 32 + 8 * q) = o; }
        __syncthreads();
        { float cum[16], run = 0.f;
#pragma unroll
          for (int p = 0; p < 16; ++p) { const int pos = pg * 16 + p; float lg = bias;
#pragma unroll
              for (int rr = 0; rr < 16; ++rr) lg += glr[pos * 16 + rr] * wv[rr];
              const float ls = fminf(lg, 0.f) - __logf(1.0f + __expf(-fabsf(lg)));
              run += ls * (1.0f / 16.0f); cum[p] = run; }
          tot[pg * 128 + dk] = run;
          __syncthreads();
          float off = 0.f, total = 0.f;
#pragma unroll
          for (int g = 0; g < 4; ++g) { const float tv = tot[g * 128 + dk]; total += tv; if (g < pg) off += tv; }
          unsigned pk[8];
#pragma unroll
          for (int p = 0; p < 8; ++p) pk[p] = pk2(bf2f(kraw[2 * p]) * __expf(total - (cum[2 * p] + off)), bf2f(kraw[2 * p + 1]) * __expf(total - (cum[2 * p + 1] + off)));
          *(LAS u32x4*)(kdT + dk * 72 + pg * 16) = (u32x4){pk[0], pk[1], pk[2], pk[3]};
          *(LAS u32x4*)(kdT + dk * 72 + pg * 16 + 8) = (u32x4){pk[4], pk[5], pk[6], pk[7]};
          if (pg == 0) DEC[(size_t)u * 128 + dk] = __expf(total); }
        if (u + GRID < 1024) G1_LOAD(u + GRID);
        __syncthreads();
        f32x16 acc[4];
#pragma unroll
        for (int db = 0; db < 4; ++db)
#pragma unroll
            for (int i = 0; i < 16; ++i) acc[db][i] = 0.f;
#pragma unroll
        for (int ks = 0; ks < 4; ++ks) { const bf16x8 bf = *(const LAS bf16x8*)(vT + (32 * w + r) * 72 + 16 * ks + 8 * hh);
#pragma unroll
            for (int db = 0; db < 4; ++db) { const bf16x8 af = *(const LAS bf16x8*)(kdT + (32 * db + r) * 72 + 16 * ks + 8 * hh); acc[db] = MFMA32(af, bf, acc[db]); } }
        { LAS bf16* orow = ot + (32 * w + r) * 132;
#pragma unroll
          for (int db = 0; db < 4; ++db)
#pragma unroll
              for (int g = 0; g < 4; ++g) *(LAS u32x2*)(orow + 32 * db + 8 * g + 4 * hh) = (u32x2){pk2(acc[db][4 * g], acc[db][4 * g + 1]), pk2(acc[db][4 * g + 2], acc[db][4 * g + 3])}; }
        __syncthreads();
        { bf16* base = UPD + (size_t)u * 32768;
#pragma unroll
          for (int ps = 0; ps < 8; ++ps) { const int row = (tid >> 4) + 32 * ps, c = tid & 15; const LAS unsigned char* sp_ = (const LAS unsigned char*)(ot + row * 132) + c * 16;
              const u32x2 lo = *(const LAS u32x2*)sp_, hi = *(const LAS u32x2*)(sp_ + 8);
              *(u32x4*)(base + (size_t)row * 128 + c * 8) = (u32x4){lo.x, lo.y, hi.x, hi.y}; } }
    }
#undef G1_LOAD
}

__device__ __forceinline__ void gla_scan_phase(Frame& F) {
    bf16* UPD = WSP(bf16, WS_UPD); const float* DEC = WSP(float, WS_DEC);
    PH_IDS();
    if (tid >= 256) return;
    const int gt = blockIdx.x * 256 + tid;
    const int bh = gt >> 13, e4 = (gt & 8191) * 4, b = bh >> 2, h = bh & 3, dk = e4 & 127;
    f32x4 st = (f32x4){0.f, 0.f, 0.f, 0.f};
    for (int c0 = 0; c0 < 128; c0 += 16) {
        u32x2 uv[16]; f32x4 dv[16];
#pragma unroll
        for (int k = 0; k < 16; ++k) { const size_t u = (size_t)((b * 128 + c0 + k) * 4 + h); uv[k] = *(const u32x2*)(UPD + u * 32768 + e4); dv[k] = *(const f32x4*)(DEC + u * 128 + dk); }
#pragma unroll
        for (int k = 0; k < 16; ++k) { const size_t u = (size_t)((b * 128 + c0 + k) * 4 + h);
            const f32x4 up = (f32x4){bflo(uv[k].x), bfhi(uv[k].x), bflo(uv[k].y), bfhi(uv[k].y)};
            st = dv[k] * st + up;
            *(u32x2*)(UPD + u * 32768 + e4) = (u32x2){pk2(st[0], st[1]), pk2(st[2], st[3])}; }
    }
}

__device__ __forceinline__ void gla_out_phase(Frame& F, const float* g_norm) {
    const bf16* HB = WSP(bf16, WS_HB); const bf16* ST = WSP(bf16, WS_UPD); bf16* MIX = WSP(bf16, WS_MIX);
    LAS float* part = (LAS float*)(F.lds);
    LAS bf16* ql = (LAS bf16*)(F.lds + 2048);
    constexpr int QP = 136, GP = 264;
    LAS bf16* Gl = (LAS bf16*)(F.lds + 2048 + 64 * QP * 2);
    LAS bf16* Ol = (LAS bf16*)(F.lds + 2048 + 64 * QP * 2 + 64 * GP * 2);
    PH_IDS(); const int w = wave, r = lane & 31, hh = lane >> 5;
    bf16x8 af[8], afn[8]; u32x4 qs[2], qsn[2], gr[4], grn[4];
#define GO_LOAD(A_, Q_, G_, u_) do { const int h_ = (u_) & 3, bc_ = (u_) >> 2, t0_ = (bc_ >> 7) * SEQ + (bc_ & 127) * 64; \
        const bf16* ar_ = ST + (size_t)(u_) * 32768 + (size_t)(32 * w + r) * 128 + 64 * hh; \
        _Pragma("unroll") for (int ks = 0; ks < 8; ++ks) A_[ks] = *(const bf16x8*)(ar_ + 8 * ks); \
        _Pragma("unroll") for (int k = 0; k < 2; ++k) { const int c = tid + 512 * k, pos = c >> 4, cc = c & 15; Q_[k] = *(const u32x4*)(HB + (size_t)(t0_ + pos) * HBW + COL_GQ + h_ * 128 + cc * 8); } \
        _Pragma("unroll") for (int k = 0; k < 4; ++k) { const int c = tid + 512 * k, pos = c >> 5, cc = c & 31; G_[k] = *(const u32x4*)(HB + (size_t)(t0_ + pos) * HBW + COL_GO + h_ * 256 + cc * 8); } } while (0)
    if (F.vcu < 1024) GO_LOAD(af, qs, gr, F.vcu);
    for (int u = F.vcu; u < 1024; u += GRID) {
        const int h = u & 3, bc = u >> 2, t0 = (bc >> 7) * SEQ + (bc & 127) * 64;
#pragma unroll
        for (int k = 0; k < 2; ++k) { const int c = tid + 512 * k, pos = c >> 4, cc = c & 15; *(LAS u32x4*)(ql + pos * QP + cc * 8) = qs[k]; }
#pragma unroll
        for (int k = 0; k < 4; ++k) { const int c = tid + 512 * k, pos = c >> 5, cc = c & 31; *(LAS u32x4*)(Gl + pos * GP + cc * 8) = gr[k]; }
        __syncthreads();
        if (u + GRID < 1024) GO_LOAD(afn, qsn, grn, u + GRID);
        f32x16 acc[2];
#pragma unroll
        for (int pb = 0; pb < 2; ++pb)
#pragma unroll
            for (int i = 0; i < 16; ++i) acc[pb][i] = 0.f;
#pragma unroll
        for (int ks = 0; ks < 8; ++ks)
#pragma unroll
            for (int pb = 0; pb < 2; ++pb) { const bf16x8 bf = *(const LAS bf16x8*)(ql + (32 * pb + r) * QP + 64 * hh + 8 * ks); acc[pb] = MFMA32(af[ks], bf, acc[pb]); }
        const float qsc = 0.08838834764831845f;
#pragma unroll
        for (int pb = 0; pb < 2; ++pb) { float ss = 0.f;
#pragma unroll
            for (int i = 0; i < 16; ++i) { acc[pb][i] *= qsc; ss += acc[pb][i] * acc[pb][i]; }
            ss += __shfl_xor(ss, 32);
            if (hh == 0) part[w * 64 + 32 * pb + r] = ss; }
        __syncthreads();
#pragma unroll
        for (int pb = 0; pb < 2; ++pb) { const int pos = 32 * pb + r; float ss = 0.f;
#pragma unroll
            for (int ww = 0; ww < 8; ++ww) ss += part[ww * 64 + pos];
            const float rs = rsqrtf(ss * (1.0f / 256.0f) + EPS);
#pragma unroll
            for (int g = 0; g < 4; ++g) { const int dv0 = 32 * w + 8 * g + 4 * hh;
                const u32x2 gq = *(const LAS u32x2*)(Gl + pos * GP + dv0);
                const f32x4 gn = *(const f32x4*)(g_norm + dv0);
                const float g0 = bflo(gq.x), g1 = bfhi(gq.x), g2 = bflo(gq.y), g3 = bfhi(gq.y);
                const float o0 = acc[pb][4 * g] * rs * gn[0] * (g0 * sigmoidf_(g0)), o1 = acc[pb][4 * g + 1] * rs * gn[1] * (g1 * sigmoidf_(g1));
                const float o2 = acc[pb][4 * g + 2] * rs * gn[2] * (g2 * sigmoidf_(g2)), o3 = acc[pb][4 * g + 3] * rs * gn[3] * (g3 * sigmoidf_(g3));
                *(LAS u32x2*)(Ol + pos * GP + dv0) = (u32x2){pk2(o0, o1), pk2(o2, o3)}; } }
        __syncthreads();
#pragma unroll
        for (int k = 0; k < 4; ++k) { const int c = tid + 512 * k, pos = c >> 5, cc = c & 31;
            *(u32x4*)(MIX + (size_t)(t0 + pos) * D + 1024 + h * 256 + cc * 8) = *(const LAS u32x4*)(Ol + pos * GP + cc * 8); }
#pragma unroll
        for (int ks = 0; ks < 8; ++ks) af[ks] = afn[ks];
        qs[0] = qsn[0]; qs[1] = qsn[1];
#pragma unroll
        for (int k = 0; k < 4; ++k) gr[k] = grn[k];
    }
#undef GO_LOAD
}

constexpr int AT_KP = 200, AT_VP = 68;
constexpr int AT_KB = 64 * AT_KP * 2, AT_VB = 128 * AT_VP * 2;
__device__ __forceinline__ void attn_unit(Frame& F, int b, int h, int qb, BgCtx& G) {
    const bf16* Qg = WSP(bf16, WS_QB) + (size_t)(b * NH + h) * SEQ * DQK;
    const bf16* Kg = WSP(bf16, WS_KB) + (size_t)(b * NH + h) * SEQ * DQK;
    const bf16* Vg = WSP(bf16, WS_VTB) + (size_t)(b * NH + h) * DV * SEQ;
    bf16* MIX = WSP(bf16, WS_MIX);
    PH_IDS(); const int w = wave, r = lane & 31, hh = lane >> 5;
    const int qrow = qb * 256 + 32 * w + r;
    bf16x8 qf[12];
#pragma unroll
    for (int ks = 0; ks < 12; ++ks) qf[ks] = *(const bf16x8*)(Qg + (size_t)qrow * DQK + 16 * ks + 8 * hh);
    const int ntiles = 4 * qb + 4, my_last = 4 * qb + (w >> 1);
    f32x16 oacc[4];
#pragma unroll
    for (int d = 0; d < 4; ++d)
#pragma unroll
        for (int i = 0; i < 16; ++i) oacc[d][i] = 0.f;
    float m_i = -INFINITY, l_i = 0.f;
    u32x4 kreg[3], vreg[2];
#define AT_LOAD(kt) do { _Pragma("unroll") for (int k = 0; k < 3; ++k) { const int c = tid + 512 * k, row = c / 24, cc = c % 24; kreg[k] = *(const u32x4*)(Kg + (size_t)((kt) * 64 + row) * DQK + cc * 8); } \
        _Pragma("unroll") for (int k = 0; k < 2; ++k) { const int c = tid + 512 * k, row = c >> 3, cc = c & 7; vreg[k] = *(const u32x4*)(Vg + (size_t)row * SEQ + (kt) * 64 + cc * 8); } } while (0)
#define AT_STORE(buf) do { LAS unsigned char* kb_ = F.lds + (buf) * (AT_KB + AT_VB); LAS unsigned char* vb_ = kb_ + AT_KB; \
        _Pragma("unroll") for (int k = 0; k < 3; ++k) { const int c = tid + 512 * k, row = c / 24, cc = c % 24; *(LAS u32x4*)(kb_ + row * (AT_KP * 2) + cc * 16) = kreg[k]; } \
        _Pragma("unroll") for (int k = 0; k < 2; ++k) { const int c = tid + 512 * k, row = c >> 3, cc = c & 7; LAS unsigned char* p_ = vb_ + row * (AT_VP * 2) + cc * 16; \
            *(LAS u32x2*)p_ = (u32x2){vreg[k].x, vreg[k].y}; *(LAS u32x2*)(p_ + 8) = (u32x2){vreg[k].z, vreg[k].w}; } } while (0)
    LAS unsigned short* bscr = (LAS unsigned short*)(F.lds + 2 * (AT_KB + AT_VB) + w * BG_SCR);
    AT_LOAD(0); AT_STORE(0);
    __builtin_amdgcn_s_waitcnt(0x0F70);
    __syncthreads();
    for (int kt = 0; kt < ntiles; ++kt) {
        const int cur = kt & 1;
        if (kt + 1 < ntiles) AT_LOAD(kt + 1);
        const bool bg = G.it < BG_ITEMS;
        f32x4 bt;
        if (bg) { if (G.q == 0) { const BgItem b0 = bg_item(G.it, G, lane); G.sp = b0.sp; G.ld8 = 8 * b0.ldsrc; }
            bt = __builtin_nontemporal_load((const f32x4*)G.sp);
            G.sp += (size_t)G.ld8; }
        if (kt <= my_last) {
            const LAS unsigned char* kb = F.lds + cur * (AT_KB + AT_VB); const LAS unsigned char* vb = kb + AT_KB;
            f32x16 sacc[2];
#pragma unroll
            for (int kbk = 0; kbk < 2; ++kbk) {
#pragma unroll
                for (int i = 0; i < 16; ++i) sacc[kbk][i] = 0.f;
#pragma unroll
                for (int ks = 0; ks < 12; ++ks) { const bf16x8 af = *(const LAS bf16x8*)(kb + (32 * kbk + r) * (AT_KP * 2) + (16 * ks + 8 * hh) * 2); sacc[kbk] = MFMA32(af, qf[ks], sacc[kbk]); } }
            float mx = sacc[0][0];
#pragma unroll
            for (int i = 1; i < 16; ++i) mx = fmaxf(mx, sacc[0][i]);
#pragma unroll
            for (int i = 0; i < 16; ++i) mx = fmaxf(mx, sacc[1][i]);
            mx = fmaxf(mx, __shfl_xor(mx, 32));
            const float m_new = fmaxf(m_i, mx), alpha = fast_exp2(m_i - m_new);
            m_i = m_new;
            float ls = 0.f;
#pragma unroll
            for (int kbk = 0; kbk < 2; ++kbk)
#pragma unroll
                for (int i = 0; i < 16; ++i) { const float p = fast_exp2(sacc[kbk][i] - m_new); sacc[kbk][i] = p; ls += p; }
            l_i = l_i * alpha + ls;
#pragma unroll
            for (int d = 0; d < 4; ++d)
#pragma unroll
                for (int i = 0; i < 16; ++i) oacc[d][i] *= alpha;
            bf16x8 pf[2][2];
#pragma unroll
            for (int kbk = 0; kbk < 2; ++kbk)
#pragma unroll
                for (int s2 = 0; s2 < 2; ++s2) { u32x4 q; q.x = pk2(sacc[kbk][8 * s2], sacc[kbk][8 * s2 + 1]); q.y = pk2(sacc[kbk][8 * s2 + 2], sacc[kbk][8 * s2 + 3]);
                    q.z = pk2(sacc[kbk][8 * s2 + 4], sacc[kbk][8 * s2 + 5]); q.w = pk2(sacc[kbk][8 * s2 + 6], sacc[kbk][8 * s2 + 7]); pf[kbk][s2] = __builtin_bit_cast(bf16x8, q); }
#pragma unroll
            for (int d = 0; d < 4; ++d)
#pragma unroll
                for (int kbk = 0; kbk < 2; ++kbk)
#pragma unroll
                    for (int s2 = 0; s2 < 2; ++s2) { const int kk = 32 * kbk + 16 * s2; const LAS unsigned char* vp = vb + (32 * d + r) * (AT_VP * 2) + (kk + 4 * hh) * 2;
                        const u32x2 v0 = *(const LAS u32x2*)vp, v1 = *(const LAS u32x2*)(vp + 16);
                        const bf16x8 af = __builtin_bit_cast(bf16x8, ((u32x4){v0.x, v0.y, v1.x, v1.y}));
                        oacc[d] = MFMA32(af, pf[kbk][s2], oacc[d]); }
        }
        if (kt + 1 < ntiles) AT_STORE(cur ^ 1);
        if (bg) { BG_PUT(bt, bscr, lane, G.q);
            if (G.q == 7) { const BgItem bi = bg_item(G.it, G, lane); BG_STORE(bi, bscr, lane); G.it += GRID * NWAVES; G.q = 0; } else ++G.q; }
        __syncthreads();
    }
#undef AT_LOAD
#undef AT_STORE
    const float lt = l_i + __shfl_xor(l_i, 32), inv = 1.0f / lt;
    bf16* orow = MIX + (size_t)(b * SEQ + qrow) * D + h * DV;
#pragma unroll
    for (int d = 0; d < 4; ++d)
#pragma unroll
        for (int g = 0; g < 4; ++g) *(u32x2*)(orow + 32 * d + 8 * g + 4 * hh) = (u32x2){pk2(oacc[d][4 * g] * inv, oacc[d][4 * g + 1] * inv), pk2(oacc[d][4 * g + 2] * inv, oacc[d][4 * g + 3] * inv)};
}
__device__ __forceinline__ void attn_phase(Frame& F, const Args& A) {
    const int bh = F.vcu >> 4, qp = F.vcu & 15;
    if (__builtin_amdgcn_readfirstlane(fresh_tid() >> 6) >= 4) __builtin_amdgcn_s_setprio(1);
    BgCtx G{(const float*)A.in[23], (const float*)A.in[24], (const float*)A.in[25], (const float*)A.in[10], (const float*)A.in[11], (const float*)A.in[16], F.ws, 0, 0, 0, nullptr};
    { PH_IDS(); G.it = F.vcu * NWAVES + wave; }
    attn_unit(F, bh >> 3, bh & 7, 31 - qp, G);
    attn_unit(F, bh >> 3, bh & 7, qp, G);
    __builtin_amdgcn_s_setprio(0);
    { PH_IDS(); LAS unsigned short* bscr = (LAS unsigned short*)(F.lds + 2 * (AT_KB + AT_VB) + wave * BG_SCR);
      for (; G.it < BG_ITEMS; G.it += GRID * NWAVES, G.q = 0) { const BgItem bi = bg_item(G.it, G, lane);
          for (int q = G.q; q < 8; ++q) { const f32x4 bt = __builtin_nontemporal_load((const f32x4*)(bi.sp + (size_t)8 * q * bi.ldsrc)); BG_PUT(bt, bscr, lane, q); }
          BG_STORE(bi, bscr, lane); } }
}

constexpr int SG_P = 136;
__device__ __forceinline__ void sgu_phase(Frame& F, const float* ln_g, const float* ln_b, const float* b_s) {
    const bf16* U = WSP(bf16, WS_U); const bf16* VT = WSP(bf16, WS_VT1); const bf16* WSM = WSP(bf16, WS_WS); const float* wsum = WSP(float, WS_WSUM);
    const float* vsum = WSP(float, WS_VSP); const float* vsq = WSP(float, WS_VQP); bf16* MIX = WSP(bf16, WS_MIX);
    LAS float* mu = (LAS float*)(F.lds); LAS float* rs = mu + 128; LAS float* c1 = mu + 256;
    LAS bf16* Wl = (LAS bf16*)(F.lds + 2048); LAS bf16* Vl = (LAS bf16*)(F.lds + 2048 + 128 * SG_P * 2);
    LAS bf16* Xl = (LAS bf16*)(F.lds + 2048 + 2 * 128 * SG_P * 2);
    constexpr int XP = 132;
    PH_IDS(); const int w = wave, r = lane & 31, hh = lane >> 5;
    f32x4 sa, sq; u32x4 wv[4], vv[4], ur[4];
    LAS float* ps = (LAS float*)(F.lds + 2048 + 2 * 128 * SG_P * 2 + 128 * XP * 2);
#define SG_LOAD(su_) do { const int g_ = (su_) & 15, t0_ = ((su_) >> 4) * 128; \
        sa = *(const f32x4*)(vsum + (size_t)(t0_ + (tid & 127)) * 16 + 4 * (tid >> 7)); sq = *(const f32x4*)(vsq + (size_t)(t0_ + (tid & 127)) * 16 + 4 * (tid >> 7)); \
        _Pragma("unroll") for (int k = 0; k < 4; ++k) { const int chunk = tid + 512 * k, i = chunk >> 4, j0 = (chunk & 15) * 8; \
            wv[k] = *(const u32x4*)(WSM + (size_t)g_ * 16384 + i * 128 + j0); vv[k] = *(const u32x4*)(VT + (size_t)(128 * g_ + i) * T + t0_ + j0); \
            ur[k] = *(const u32x4*)(U + (size_t)(t0_ + i) * D + 128 * g_ + j0); } } while (0)
    if (F.vcu < 2048) SG_LOAD(F.vcu);
    for (int su = F.vcu; su < 2048; su += GRID) {
        const int g = su & 15, t0 = (su >> 4) * 128;
        ps[tid] = (sa[0] + sa[1]) + (sa[2] + sa[3]); ps[512 + tid] = (sq[0] + sq[1]) + (sq[2] + sq[3]);
        __syncthreads();
        if (tid < 128) { float s = 0.f, q = 0.f;
#pragma unroll
            for (int k = 0; k < 4; ++k) { s += ps[128 * k + tid]; q += ps[512 + 128 * k + tid]; }
            const float mean = s * (1.0f / 2048.0f), var = fmaxf(q * (1.0f / 2048.0f) - mean * mean, 0.f);
            mu[tid] = mean; rs[tid] = rsqrtf(var + EPS); }
        __syncthreads();
#pragma unroll
        for (int k = 0; k < 4; ++k) { const int chunk = tid + 512 * k, i = chunk >> 4, j0 = (chunk & 15) * 8;
            float wf[8] = {bflo(wv[k].x), bfhi(wv[k].x), bflo(wv[k].y), bfhi(wv[k].y), bflo(wv[k].z), bfhi(wv[k].z), bflo(wv[k].w), bfhi(wv[k].w)}; float cs = 0.f;
#pragma unroll
            for (int jj = 0; jj < 8; ++jj) { wf[jj] *= rs[j0 + jj]; cs += wf[jj] * mu[j0 + jj]; }
            *(LAS u32x4*)(Wl + i * SG_P + j0) = (u32x4){pk2(wf[0], wf[1]), pk2(wf[2], wf[3]), pk2(wf[4], wf[5]), pk2(wf[6], wf[7])};
#pragma unroll
            for (int o = 1; o < 16; o <<= 1) cs += __shfl_xor(cs, o);
            if ((lane & 15) == 0) c1[i] = cs;
            *(LAS u32x4*)(Vl + i * SG_P + j0) = vv[k];
            { LAS unsigned char* xp_ = (LAS unsigned char*)(Xl + i * XP + j0); *(LAS u32x2*)xp_ = (u32x2){ur[k].x, ur[k].y}; *(LAS u32x2*)(xp_ + 8) = (u32x2){ur[k].z, ur[k].w}; } }
        __syncthreads();
        if (su + GRID < 2048) SG_LOAD(su + GRID);
        const int mb = w & 3; u32x2 uu[2][4];
#pragma unroll
        for (int nb = 0; nb < 2; ++nb)
#pragma unroll
            for (int q = 0; q < 4; ++q) uu[nb][q] = *(const LAS u32x2*)(Xl + (32 * (2 * (w >> 2) + nb) + r) * XP + 32 * mb + 8 * q + 4 * hh);
        f32x16 acc[2];
#pragma unroll
        for (int nb = 0; nb < 2; ++nb)
#pragma unroll
            for (int i = 0; i < 16; ++i) acc[nb][i] = 0.f;
#pragma unroll
        for (int ks = 0; ks < 8; ++ks) { const bf16x8 af = *(const LAS bf16x8*)(Vl + (32 * mb + r) * SG_P + 16 * ks + 8 * hh);
#pragma unroll
            for (int nb = 0; nb < 2; ++nb) { const bf16x8 bf = *(const LAS bf16x8*)(Wl + (32 * (2 * (w >> 2) + nb) + r) * SG_P + 16 * ks + 8 * hh); acc[nb] = MFMA32(af, bf, acc[nb]); } }
        __syncthreads();
#pragma unroll
        for (int nb = 0; nb < 2; ++nb) { const int i = 32 * (2 * (w >> 2) + nb) + r;
            const float c1i = c1[i], wsi = wsum[g * 128 + i], bsi = b_s[g * 128 + i];
#pragma unroll
            for (int q = 0; q < 4; ++q) { const int ch = 128 * g + 32 * mb + 8 * q + 4 * hh;
                const f32x4 lg = *(const f32x4*)(ln_g + ch), lb = *(const f32x4*)(ln_b + ch); const u32x2 u2 = uu[nb][q];
                const float o0 = bflo(u2.x) * (lg[0] * (acc[nb][4 * q] - c1i) + lb[0] * wsi + bsi), o1 = bfhi(u2.x) * (lg[1] * (acc[nb][4 * q + 1] - c1i) + lb[1] * wsi + bsi);
                const float o2 = bflo(u2.y) * (lg[2] * (acc[nb][4 * q + 2] - c1i) + lb[2] * wsi + bsi), o3 = bfhi(u2.y) * (lg[3] * (acc[nb][4 * q + 3] - c1i) + lb[3] * wsi + bsi);
                *(LAS u32x2*)(Xl + i * XP + 32 * mb + 8 * q + 4 * hh) = (u32x2){pk2(o0, o1), pk2(o2, o3)}; } }
        __syncthreads();
#pragma unroll
        for (int ps = 0; ps < 4; ++ps) { const int row = (tid >> 4) + 32 * ps, c = tid & 15; const LAS unsigned char* xp_ = (const LAS unsigned char*)(Xl + row * XP + 8 * c);
            const u32x2 lo = *(const LAS u32x2*)xp_, hi = *(const LAS u32x2*)(xp_ + 8);
            *(u32x4*)(MIX + (size_t)(t0 + row) * D + 128 * g + 8 * c) = (u32x4){lo.x, lo.y, hi.x, hi.y}; }
    }
#undef SG_LOAD
}

__device__ __forceinline__ float wave_sum16(float v) { return wave_sum(v); }
__device__ __forceinline__ void ln_route_phase(Frame& F, const float* lng, const float* lnb, const float* router_w, const float* router_b, int layer) {
    const bf16* PRE = WSP(bf16, WS_PRE); bf16* X1 = WSP(bf16, WS_X1); int* LIST = WSP(int, WS_LIST); unsigned* REC = WSP(unsigned, WS_REC);
    unsigned* gcnt = (unsigned*)(F.ctl + CW_CNT + layer * 16 * 64);
    LAS float* rw = (LAS float*)(F.lds);
    volatile LAS unsigned* M = F.MISC;
    PH_IDS(); const int w = wave;
    for (int idx = tid; idx < D * NE; idx += NTHR) rw[(idx & 15) * D + (idx >> 4)] = router_w[idx];
    if (tid < 16) M[MW_LCNT + tid] = 0u;
    __syncthreads();
    float rb[16];
#pragma unroll
    for (int e = 0; e < 16; ++e) rb[e] = router_b[e];
    u32x2 prow[2][8];
#define LN1_LOAD(k, pb) do { const u32x2* pr_ = (const u32x2*)(PRE + (size_t)(F.vcu * 64 + w * 8 + (k)) * D) + lane; _Pragma("unroll") for (int j = 0; j < 8; ++j) prow[pb][j] = pr_[64 * j]; } while (0)
#define LN1_BODY(k, PB) do { \
        const int lt = w * 8 + k, tok = F.vcu * 64 + lt; \
        if (k + 1 < 8) LN1_LOAD(k + 1, 1 - PB); \
        f32x4 v[8]; float s = 0.f; \
_Pragma("unroll") \
        for (int j = 0; j < 8; ++j) { const u32x2 pq = prow[PB][j]; v[j] = (f32x4){bflo(pq.x), bfhi(pq.x), bflo(pq.y), bfhi(pq.y)}; \
            s += (v[j][0] + v[j][1]) + (v[j][2] + v[j][3]); } \
        const float mean = wave_sum(s) * (1.0f / D); float s2 = 0.f; \
_Pragma("unroll") \
        for (int j = 0; j < 8; ++j) { v[j] = v[j] - mean; s2 += (v[j][0] * v[j][0] + v[j][1] * v[j][1]) + (v[j][2] * v[j][2] + v[j][3] * v[j][3]); } \
        const float rstd = rsqrtf(wave_sum(s2) * (1.0f / D) + EPS); \
        u32x2* xo = (u32x2*)(X1 + (size_t)tok * D) + lane; \
_Pragma("unroll") \
        for (int j = 0; j < 8; ++j) { const f32x4 g = *((const f32x4*)lng + lane + 64 * j), bb = *((const f32x4*)lnb + lane + 64 * j); v[j] = v[j] * rstd * g + bb; \
            xo[64 * j] = (u32x2){pk2(v[j][0], v[j][1]), pk2(v[j][2], v[j][3])}; } \
        float lg[16], pt[16]; \
_Pragma("unroll") \
        for (int e = 0; e < 16; ++e) { f32x2 a2 = {0.f, 0.f}; \
_Pragma("unroll") \
            for (int j = 0; j < 8; ++j) { const f32x4 q = *(const LAS f32x4*)(rw + e * D + 256 * j + 4 * lane); a2 += (f32x2){v[j][0], v[j][1]} * (f32x2){q[0], q[1]}; a2 += (f32x2){v[j][2], v[j][3]} * (f32x2){q[2], q[3]}; } \
            pt[e] = a2[0] + a2[1]; } \
        {   \
          const bool b5 = (lane & 32) != 0, b4 = (lane & 16) != 0, b3 = (lane & 8) != 0, b2 = (lane & 4) != 0; float p8[8], p4[4], p2[2], p1; \
          _Pragma("unroll") for (int i = 0; i < 8; ++i) p8[i] = (b5 ? pt[i + 8] : pt[i]) + __shfl_xor(b5 ? pt[i] : pt[i + 8], 32); \
          _Pragma("unroll") for (int i = 0; i < 4; ++i) p4[i] = (b4 ? p8[i + 4] : p8[i]) + __shfl_xor(b4 ? p8[i] : p8[i + 4], 16); \
          _Pragma("unroll") for (int i = 0; i < 2; ++i) p2[i] = (b3 ? p4[i + 2] : p4[i]) + __shfl_xor(b3 ? p4[i] : p4[i + 2], 8); \
          p1 = (b2 ? p2[1] : p2[0]) + __shfl_xor(b2 ? p2[0] : p2[1], 4); p1 += __shfl_xor(p1, 2); p1 += __shfl_xor(p1, 1); \
          _Pragma("unroll") for (int e = 0; e < 16; ++e) lg[e] = __shfl(p1, 32 * (e >> 3) + 16 * ((e >> 2) & 1) + 8 * ((e >> 1) & 1) + 4 * (e & 1)); } \
        float sc[16], bs[16]; \
_Pragma("unroll") \
        for (int e = 0; e < 16; ++e) { sc[e] = 1.0f / (1.0f + __expf(-lg[e])); bs[e] = sc[e] + rb[e]; } \
        float gs[4]; \
_Pragma("unroll") \
        for (int g = 0; g < 4; ++g) { const float a0 = bs[4 * g], a1 = bs[4 * g + 1], a2 = bs[4 * g + 2], a3 = bs[4 * g + 3]; \
            const float h01 = fmaxf(a0, a1), l01 = fminf(a0, a1), h23 = fmaxf(a2, a3), l23 = fminf(a2, a3); \
            const float t1 = fmaxf(h01, h23), t2 = fmaxf(fminf(h01, h23), (h01 >= h23) ? l01 : l23); gs[g] = t1 + t2; } \
        int best = 0; float bv = gs[0]; \
_Pragma("unroll") \
        for (int g = 1; g < 4; ++g) if (gs[g] > bv) { bv = gs[g]; best = g; } \
        float cb[4], cs[4]; \
_Pragma("unroll") \
        for (int i = 0; i < 4; ++i) { cb[i] = best == 0 ? bs[i] : best == 1 ? bs[4 + i] : best == 2 ? bs[8 + i] : bs[12 + i]; cs[i] = best == 0 ? sc[i] : best == 1 ? sc[4 + i] : best == 2 ? sc[8 + i] : sc[12 + i]; } \
        int i0 = 0; float v0 = cb[0]; \
_Pragma("unroll") \
        for (int i = 1; i < 4; ++i) if (cb[i] > v0) { v0 = cb[i]; i0 = i; } \
        int i1 = -1; float v1 = -INFINITY; \
_Pragma("unroll") \
        for (int i = 0; i < 4; ++i) if (i != i0 && cb[i] > v1) { v1 = cb[i]; i1 = i; } \
        const float s0 = i0 == 0 ? cs[0] : i0 == 1 ? cs[1] : i0 == 2 ? cs[2] : cs[3], s1 = i1 == 0 ? cs[0] : i1 == 1 ? cs[1] : i1 == 2 ? cs[2] : cs[3]; \
        const float g0 = s0 / (s0 + s1), g1 = s1 / (s0 + s1); \
        const int e0 = 4 * best + i0, e1 = 4 * best + i1; \
        if (lane == 0) { const unsigned p0 = __hip_atomic_fetch_add((LAS unsigned*)(M + MW_LCNT + e0), 1u, __ATOMIC_RELAXED, __HIP_MEMORY_SCOPE_WORKGROUP), p1 = __hip_atomic_fetch_add((LAS unsigned*)(M + MW_LCNT + e1), 1u, __ATOMIC_RELAXED, __HIP_MEMORY_SCOPE_WORKGROUP); \
            M[MW_REC + lt * 8 + 0] = (unsigned)e0; M[MW_REC + lt * 8 + 1] = (unsigned)e1; M[MW_REC + lt * 8 + 2] = p0; M[MW_REC + lt * 8 + 3] = p1; \
            M[MW_REC + lt * 8 + 4] = __builtin_bit_cast(unsigned, g0); M[MW_REC + lt * 8 + 5] = __builtin_bit_cast(unsigned, g1); } \
    } while (0)
    LN1_LOAD(0, 0);
    for (int kk = 0; kk < 8; kk += 2) { { const int k = kk; LN1_BODY(k, 0); } { const int k = kk + 1; LN1_BODY(k, 1); } }
#undef LN1_BODY
#undef LN1_LOAD
    __syncthreads();
    if (tid < 16) M[MW_LBASE + tid] = __hip_atomic_fetch_add(gcnt + tid * 64, M[MW_LCNT + tid], RLX_AGENT);
    __syncthreads();
    if (tid < 64) { const int tok = F.vcu * 64 + tid; const unsigned e0 = M[MW_REC + tid * 8], e1 = M[MW_REC + tid * 8 + 1];
        const unsigned p0 = M[MW_LBASE + e0] + M[MW_REC + tid * 8 + 2], p1 = M[MW_LBASE + e1] + M[MW_REC + tid * 8 + 3];
        LIST[e0 * T + p0] = tok; LIST[e1 * T + p1] = tok;
        *(u32x4*)(REC + (size_t)tok * 8) = (u32x4){e0, e1, p0, p1}; *(u32x2*)(REC + (size_t)tok * 8 + 4) = (u32x2){M[MW_REC + tid * 8 + 4], M[MW_REC + tid * 8 + 5]}; }
    __syncthreads();
}

__device__ __forceinline__ void moe_tables(Frame& F, int layer) {
    if (threadIdx.x == 0) { unsigned acc = 0;
        for (int e = 0; e < 16; ++e) { const unsigned c = __hip_atomic_load((unsigned*)(F.ctl + CW_CNT + (layer * 16 + e) * 64), RLX_AGENT); F.MISC[MW_CNT + e] = c; F.MISC[MW_TP + e] = acc; acc += (c + 255u) >> 8; }
        F.MISC[MW_TP + 16] = acc; }
    __syncthreads();
}
template <bool UP> struct MoeOrder {
    volatile LAS unsigned* M; const int* LIST; const char* A; const char* W; int G, c, nN; int e_lo = 0, e_hi = 16, nHead = 0, K = 0;
    __device__ __forceinline__ bool next(int i, pg8::Unit& u) const {
        const int base = (int)M[MW_TP + e_lo] * nN, total = (int)M[MW_TP + e_hi] * nN - base; const int nb = G - nHead;
        const long L = (nHead == 0) ? (long)i * G + c : (c >= nHead ? (i < K ? (long)i * nb + (c - nHead) : (long)K * nb + (long)(i - K) * G + c) : (long)K * nb + (long)i * G + c);
        if (L >= total) return false;
        int wgid = (int)L; { const int q = total / 8, r = total % 8, xcd = wgid % 8, off = wgid / 8; wgid = (xcd < r ? xcd * (q + 1) : r * (q + 1) + (xcd - r) * q) + off; }
        wgid += base;
        int e = 0;
#pragma unroll
        for (int k = 1; k < 16; ++k) if (wgid >= (int)M[MW_TP + k] * nN) e = k;
        const int tp = (int)M[MW_TP + e], nmt = (int)M[MW_TP + e + 1] - tp, idx = wgid - tp * nN;
        u.pm = idx % nmt; u.pn = idx / nmt; u.aux = e; u.aux2 = 256 * (tp + u.pm);
        if (UP) { u.a = A; u.b = W + ((size_t)e * 1024 + (size_t)u.pn * 256) * D * 2; }
        else { u.a = A + (size_t)u.aux2 * DE * 2; u.b = W + ((size_t)e * D + (size_t)u.pn * 256) * DE * 2; }
        return true; }
    __device__ __forceinline__ unsigned row_off(const pg8::Unit& u, int r) const {
        const int m = u.pm * 256 + r; const int tok = (m < (int)M[MW_CNT + u.aux]) ? LIST[u.aux * T + m] : 0; return (unsigned)tok * (unsigned)(D * 2); }
};

template <bool FINAL> __device__ __forceinline__ void ln_ffn_phase(Frame& F, const float* lng, const float* lnb, float* out) {
    const bf16* X1 = WSP(bf16, WS_X1); const bf16* YS = WSP(bf16, WS_YS); const unsigned* REC = WSP(unsigned, WS_REC); bf16* XB = WSP(bf16, WS_XB);
    PH_IDS(); const int w = wave; const int tok0 = F.vcu * 64 + w * 8;
    LAS unsigned* RT = (LAS unsigned*)(F.lds);
    if (tid < 64) { const unsigned* rc = REC + (size_t)(F.vcu * 64 + tid) * 8; const unsigned e0 = rc[0], e1 = rc[1], p0 = rc[2], p1 = rc[3];
        RT[tid * 4 + 0] = F.MISC[MW_TP + e0] * 256u + p0; RT[tid * 4 + 1] = F.MISC[MW_TP + e1] * 256u + p1; RT[tid * 4 + 2] = rc[4]; RT[tid * 4 + 3] = rc[5]; }
    __syncthreads();
    u32x4 ra[3][4], rp[3][4], rq[3][4];
#define LN2_LOAD(k, pb) do { const u32x4* xp_ = (const u32x4*)(X1 + (size_t)(tok0 + (k)) * D) + lane; const u32x4* y0_ = (const u32x4*)(YS + (size_t)RT[(w * 8 + (k)) * 4] * D) + lane; const u32x4* y1_ = (const u32x4*)(YS + (size_t)RT[(w * 8 + (k)) * 4 + 1] * D) + lane; \
        _Pragma("unroll") for (int j = 0; j < 4; ++j) { ra[pb][j] = xp_[64 * j]; rp[pb][j] = y0_[64 * j]; rq[pb][j] = y1_[64 * j]; } } while (0)
#define LN2_MIX(a_, p_, q_) (f32x4){ALPHA * bflo(a_.x) + ga * bflo(p_.x) + gb * bflo(q_.x), ALPHA * bfhi(a_.x) + ga * bfhi(p_.x) + gb * bfhi(q_.x), ALPHA * bflo(a_.y) + ga * bflo(p_.y) + gb * bflo(q_.y), ALPHA * bfhi(a_.y) + ga * bfhi(p_.y) + gb * bfhi(q_.y)}
#define LN2_BODY(k, PB) do { \
        const int tok = tok0 + (k); \
        if ((k) + 2 < 8) LN2_LOAD((k) + 2, ((k) + 2) % 3); \
        f32x4 v[8]; float s = 0.f; const float ga = __builtin_bit_cast(float, RT[(w * 8 + (k)) * 4 + 2]), gb = __builtin_bit_cast(float, RT[(w * 8 + (k)) * 4 + 3]); \
        _Pragma("unroll") for (int j = 0; j < 4; ++j) { const u32x4 a = ra[PB][j], p = rp[PB][j], q = rq[PB][j]; \
            const u32x2 a0 = {a.x, a.y}, a1 = {a.z, a.w}, p0 = {p.x, p.y}, p1 = {p.z, p.w}, q0 = {q.x, q.y}, q1 = {q.z, q.w}; \
            v[2 * j] = LN2_MIX(a0, p0, q0); v[2 * j + 1] = LN2_MIX(a1, p1, q1); \
            s += ((v[2 * j][0] + v[2 * j][1]) + (v[2 * j][2] + v[2 * j][3])) + ((v[2 * j + 1][0] + v[2 * j + 1][1]) + (v[2 * j + 1][2] + v[2 * j + 1][3])); } \
        const float mean = wave_sum(s) * (1.0f / D); float s2 = 0.f; \
        _Pragma("unroll") for (int j = 0; j < 8; ++j) { v[j] = v[j] - mean; s2 += (v[j][0] * v[j][0] + v[j][1] * v[j][1]) + (v[j][2] * v[j][2] + v[j][3] * v[j][3]); } \
        const float rstd = rsqrtf(wave_sum(s2) * (1.0f / D) + EPS); \
        _Pragma("unroll") for (int j = 0; j < 4; ++j) { const f32x4* gp = (const f32x4*)lng + 2 * (lane + 64 * j); const f32x4* bp = (const f32x4*)lnb + 2 * (lane + 64 * j); \
            v[2 * j] = v[2 * j] * rstd * gp[0] + bp[0]; v[2 * j + 1] = v[2 * j + 1] * rstd * gp[1] + bp[1]; \
            if (FINAL) { f32x4* op = (f32x4*)(out + (size_t)tok * D) + 2 * (lane + 64 * j); op[0] = v[2 * j]; op[1] = v[2 * j + 1]; } \
            else *((u32x4*)(XB + (size_t)tok * D) + lane + 64 * j) = pack8(v[2 * j], v[2 * j + 1]); } } while (0)
    LN2_LOAD(0, 0); LN2_LOAD(1, 1);
    LN2_BODY(0, 0); __builtin_amdgcn_sched_barrier(0); LN2_BODY(1, 1); __builtin_amdgcn_sched_barrier(0); LN2_BODY(2, 2); __builtin_amdgcn_sched_barrier(0); LN2_BODY(3, 0); __builtin_amdgcn_sched_barrier(0);
    LN2_BODY(4, 1); __builtin_amdgcn_sched_barrier(0); LN2_BODY(5, 2); __builtin_amdgcn_sched_barrier(0); LN2_BODY(6, 0); __builtin_amdgcn_sched_barrier(0); LN2_BODY(7, 1);
#undef LN2_BODY
#undef LN2_MIX
#undef LN2_LOAD
    __syncthreads();
}


__global__ void __launch_bounds__(NTHR, 2) fwd_kernel(Args args) {
    extern __shared__ __attribute__((aligned(16))) unsigned char lds_raw[];
    Frame F;
    F.lds = (LAS unsigned char*)lds_raw; F.MISC = (volatile LAS unsigned*)(F.lds + MISC_OFF);
    { const int bx = blockIdx.x; F.vcu = (bx % 8) * (GRID / 8) + bx / 8; }
    F.ws = args.ws; F.ctl = (gu32*)(args.ws + WS_CTL);
    for (int u = threadIdx.x; u < (LDS_BYTES - MISC_OFF) / 4; u += NTHR) F.MISC[u] = 0u;
    __syncthreads();
    XcdBarrier bar = xcd_barrier_post((unsigned*)(F.ctl + CW_BAR), F.MISC + MW_BAR);
#define GRID_BAR() xcd_barrier(bar)
    LAS unsigned char* ring = F.lds;
    const int bx = (int)blockIdx.x;
    float* rsq = WSP(float, WS_RSQP); float* rskv = WSP(float, WS_RSKVP);

    p0_prologue(F, args);
    GRID_BAR();

    { pg8::PlainOrder S; S.init(WSP(bf16, WS_XB), WSP(bf16, WS_WIN0), T, 4096, D, D, GRID, bx);
      EpiIn0 E{WSP(bf16, WS_HB), rsq, rskv};
      pg8::gemm_phase<EpiIn0, pg8::PlainOrder, false>(ring, D, D, D, S, E);
    }
    { pg8::PlainOrder S; S.init(WSP(bf16, WS_XB), WSP(bf16, WS_WX0), T, 256, D, D, GRID, bx, 4, 512);
      EpiExtra E{WSP(float, WS_EXTRA)};
      pg8::gemm_phase<EpiExtra, pg8::PlainOrder, false>(ring, 512, D, D, S, E); }
    GRID_BAR();
    { pg8::PlainOrder S; S.init(WSP(bf16, WS_HB) + COL_CQ, WSP(bf16, WS_WUQ), T, 1536, HBW, 512, GRID, bx);
      EpiQ E{WSP(bf16, WS_QB), rsq, WSP(float, WS_COS), WSP(float, WS_SIN)};
      pg8::gemm_phase<EpiQ, pg8::PlainOrder, false>(ring, 512, HBW, 512, S, E); }
    { pg8::PlainOrder S; S.init(WSP(bf16, WS_HB) + COL_CKV, WSP(bf16, WS_WUK), T, 1024, HBW, 512, GRID, bx);
      EpiK E{WSP(bf16, WS_KB), rskv};
      pg8::gemm_phase<EpiK, pg8::PlainOrder, false>(ring, 512, HBW, 512, S, E); }
    { pg8::PlainOrder S; S.init(WSP(bf16, WS_WUV), WSP(bf16, WS_HB) + COL_CKV, 1024, T, 512, HBW, GRID, bx);
      EpiVt E{WSP(bf16, WS_VTB), rskv};
      pg8::gemm_phase<EpiVt, pg8::PlainOrder, false>(ring, 512, 512, HBW, S, E); }
    gla_upd_phase(F, (const float*)args.in[7], (const float*)args.in[8]);
    krot_phase(F);
    GRID_BAR();
    attn_phase(F, args);
    gla_scan_phase(F);
    GRID_BAR();
    gla_out_phase(F, (const float*)args.in[9]);
    GRID_BAR();
    { pg8::PlainOrder S; S.init(WSP(bf16, WS_MIX), WSP(bf16, WS_WO0), T, D, D, D, GRID, bx);
      EpiPre<false> E{WSP(bf16, WS_PRE), (const float*)args.in[0], nullptr};
      pg8::gemm_phase<EpiPre<false>, pg8::PlainOrder, false>(ring, D, D, D, S, E); }
    GRID_BAR();
    ln_route_phase(F, (const float*)args.in[17], (const float*)args.in[18], (const float*)args.in[21], (const float*)args.in[22], 0);
    GRID_BAR();
    moe_tables(F, 0);
    { MoeOrder<true> S{F.MISC, WSP(int, WS_LIST), (const char*)WSP(bf16, WS_X1), (const char*)WSP(bf16, WS_WGU0), GRID, bx, 4};
      EpiMoeUp E{WSP(bf16, WS_HM)};
      pg8::gemm_phase<EpiMoeUp, MoeOrder<true>, true>(ring, D, D, D, S, E); }
    { const int rem = ((int)F.MISC[MW_TP + 16] * 4) % GRID; const int first = (rem > 0 && rem <= GRID / 2) ? rem : 0;
      if (bx >= first) cvt_moe_layer(F, (const float*)args.in[23] + (size_t)NE * D * DE, (const float*)args.in[24] + (size_t)NE * D * DE, (const float*)args.in[25] + (size_t)NE * D * DE,
                  WSP(bf16, WS_WGU1), WSP(bf16, WS_WD1), first, 0, MOE_CVT_SPLIT); }
    GRID_BAR();
    { MoeOrder<false> S{F.MISC, WSP(int, WS_LIST), (const char*)WSP(bf16, WS_HM), (const char*)WSP(bf16, WS_WD0), GRID, bx, 8};
      EpiMoeDown E{WSP(bf16, WS_YS)};
      pg8::gemm_phase<EpiMoeDown, MoeOrder<false>, false>(ring, DE, DE, DE, S, E); }
    { const int rem = ((int)F.MISC[MW_TP + 16] * 8) % GRID; const int first = (rem > 0 && rem <= GRID / 2) ? rem : 0;
      if (bx >= first) cvt_moe_layer(F, (const float*)args.in[23] + (size_t)NE * D * DE, (const float*)args.in[24] + (size_t)NE * D * DE, (const float*)args.in[25] + (size_t)NE * D * DE,
                  WSP(bf16, WS_WGU1), WSP(bf16, WS_WD1), first, MOE_CVT_SPLIT, 16 * 32 * 32 + 16 * 8 * 64); }
    GRID_BAR();
    ln_ffn_phase<false>(F, (const float*)args.in[19], (const float*)args.in[20], nullptr);
    GRID_BAR();

    { pg8::PlainOrder S; S.init(WSP(bf16, WS_XB), WSP(bf16, WS_WIN1), T, D, D, D, GRID, bx);
      EpiU E{WSP(bf16, WS_U)};
      pg8::gemm_phase<EpiU, pg8::PlainOrder, false>(ring, D, D, D, S, E); }
    { pg8::PlainOrder S; S.init(WSP(bf16, WS_WIN1) + (size_t)D * D, WSP(bf16, WS_XB), D, T, D, D, GRID, bx);
      EpiVT1 E{WSP(bf16, WS_VT1), WSP(float, WS_VSP), WSP(float, WS_VQP)};
      pg8::gemm_phase<EpiVT1, pg8::PlainOrder, false>(ring, D, D, D, S, E); }
    GRID_BAR();
    sgu_phase(F, (const float*)args.in[12], (const float*)args.in[13], (const float*)args.in[15]);
    GRID_BAR();
    { pg8::PlainOrder S; S.init(WSP(bf16, WS_MIX), WSP(bf16, WS_WO1), T, D, D, D, GRID, bx);
      EpiPre<true> E{WSP(bf16, WS_PRE), nullptr, WSP(bf16, WS_XB)};
      pg8::gemm_phase<EpiPre<true>, pg8::PlainOrder, false>(ring, D, D, D, S, E); }
    GRID_BAR();
    ln_route_phase(F, (const float*)args.in[17] + D, (const float*)args.in[18] + D, (const float*)args.in[21], (const float*)args.in[22], 1);
    GRID_BAR();
    moe_tables(F, 1);
    int E1 = 0, nHead = 0;
    { const int full = ((int)F.MISC[MW_TP + 16] * 4 / GRID) * GRID;
#pragma unroll
      for (int e = 1; e <= 16; ++e) if ((int)F.MISC[MW_TP + e] * 4 <= full) E1 = e;
      const int nUp = ((int)F.MISC[MW_TP + 16] - (int)F.MISC[MW_TP + E1]) * 4; nHead = (nUp + 7) & ~7; if (nHead > GRID) nHead = GRID; }
    { MoeOrder<true> S{F.MISC, WSP(int, WS_LIST), (const char*)WSP(bf16, WS_X1), (const char*)WSP(bf16, WS_WGU1), GRID, bx, 4, 0, E1};
      EpiMoeUp E{WSP(bf16, WS_HM)};
      pg8::gemm_phase<EpiMoeUp, MoeOrder<true>, true>(ring, D, D, D, S, E); }
    GRID_BAR();
    { MoeOrder<true> S{F.MISC, WSP(int, WS_LIST), (const char*)WSP(bf16, WS_X1), (const char*)WSP(bf16, WS_WGU1), GRID, bx, 4, E1, 16};
      EpiMoeUp E{WSP(bf16, WS_HM)};
      pg8::gemm_phase<EpiMoeUp, MoeOrder<true>, true>(ring, D, D, D, S, E); }
    { MoeOrder<false> S{F.MISC, WSP(int, WS_LIST), (const char*)WSP(bf16, WS_HM), (const char*)WSP(bf16, WS_WD1), GRID, bx, 8, 0, E1, nHead, 4};
      EpiMoeDown E{WSP(bf16, WS_YS)};
      pg8::gemm_phase<EpiMoeDown, MoeOrder<false>, false>(ring, DE, DE, DE, S, E); }
    GRID_BAR();
    { MoeOrder<false> S{F.MISC, WSP(int, WS_LIST), (const char*)WSP(bf16, WS_HM), (const char*)WSP(bf16, WS_WD1), GRID, bx, 8, E1, 16};
      EpiMoeDown E{WSP(bf16, WS_YS)};
      pg8::gemm_phase<EpiMoeDown, MoeOrder<false>, false>(ring, DE, DE, DE, S, E); }
    GRID_BAR();
    ln_ffn_phase<true>(F, (const float*)args.in[19] + D, (const float*)args.in[20] + D, args.out);
}

extern "C" void kernel_launch(void* const* d_in, const int* in_sizes, int n_in, void* d_out, int out_size, void* d_ws, size_t ws_size, hipStream_t stream) {
    static int ready = 0;
    if (ready == 0) {
        if (n_in != 26 || in_sizes[0] != T * D || out_size != T * D || ws_size < WS_END) { fprintf(stderr, "kernel_launch: unexpected shapes (n_in %d, in0 %d, out %d, ws %zu < %zu)\n", n_in, n_in > 0 ? in_sizes[0] : -1, out_size, ws_size, (size_t)WS_END); ready = -1; return; }
        if (hipFuncSetAttribute((const void*)fwd_kernel, hipFuncAttributeMaxDynamicSharedMemorySize, LDS_BYTES) != hipSuccess) { fprintf(stderr, "kernel_launch: hipFuncSetAttribute failed\n"); ready = -1; return; }
        int per_cu = 0, dev = 0, cus = 0;
        (void)hipGetDevice(&dev); (void)hipDeviceGetAttribute(&cus, hipDeviceAttributeMultiprocessorCount, dev);
        if (hipOccupancyMaxActiveBlocksPerMultiprocessor(&per_cu, (const void*)fwd_kernel, NTHR, LDS_BYTES) != hipSuccess || per_cu < 1 || cus < GRID) {
            fprintf(stderr, "kernel_launch: occupancy query reports %d blocks per CU on %d CUs; the kernel needs %d resident workgroups\n", per_cu, cus, GRID); }
        (void)hipGetLastError();
        ready = 1;
    }
    if (ready < 0) return;
    if (hipMemsetAsync((char*)d_ws + WS_CTL, 0, CTL_ZERO_BYTES, stream) != hipSuccess) { fprintf(stderr, "kernel_launch: hipMemsetAsync failed\n"); return; }
    Args a{};
    for (int i = 0; i < 26; ++i) a.in[i] = d_in[i];
    a.out = (float*)d_out; a.ws = (unsigned char*)d_ws;
    hipLaunchKernelGGL(fwd_kernel, dim3(GRID), dim3(NTHR), LDS_BYTES, stream, a);
}
```

```cpp
#include <hip/hip_runtime.h>
#include <cstdio>
#include <cstdint>

#define GAS __attribute__((address_space(1)))
#define LAS __attribute__((address_space(3)))
typedef unsigned short bf16;
typedef short bf16x8 __attribute__((ext_vector_type(8)));
typedef short s16x4 __attribute__((ext_vector_type(4)));
typedef float f32x4 __attribute__((ext_vector_type(4)));
typedef float f32x2 __attribute__((ext_vector_type(2)));
typedef float f32x16 __attribute__((ext_vector_type(16)));
typedef unsigned u32x4 __attribute__((ext_vector_type(4)));
typedef unsigned u32x2 __attribute__((ext_vector_type(2)));
typedef __bf16 bf16x2_t __attribute__((ext_vector_type(2)));
typedef GAS unsigned gu32;

constexpr int T = 16384, D = 2048, SEQ = 8192, NB = 2;
constexpr int NH = 8, DQK = 192, DV = 128;
constexpr int GH = 4, GDK = 128, GDV = 256;
constexpr int NE = 16, DE = 512;
constexpr int HBW = 4096;
constexpr int COL_CQ = 0, COL_CKV = 512, COL_GQ = 1024, COL_GK = 1536, COL_GV = 2048, COL_GO = 3072;
constexpr float ALPHA = 1.41421356237309515f;
constexpr float EPS = 1e-6f;
constexpr float QSCALE = 0.07216878364870322f * 1.4426950408889634f;
constexpr int GRID = 256, NTHR = 512, NWAVES = 8;

constexpr size_t MiB = 1u << 20;
constexpr size_t WS_CTL = 0, CTL_ZERO_BYTES = 64 * 1024;
constexpr size_t WS_COS = 1 * MiB, WS_SIN = 3 * MiB, WS_DEC = 5 * MiB, WS_REC = 6 * MiB, WS_LIST = 7 * MiB, WS_WS = 8 * MiB, WS_WSUM = 8 * MiB + 512 * 1024;
constexpr size_t WS_RSQP = 9 * MiB, WS_RSKVP = 9 * MiB + 512 * 1024, WS_VSP = 10 * MiB, WS_VQP = 11 * MiB;
constexpr size_t WS_WIN0 = 16 * MiB, WS_WX0 = 32 * MiB, WS_WUQ = 33 * MiB, WS_WUK = 35 * MiB, WS_WUV = 36 * MiB, WS_WO0 = 38 * MiB, WS_WIN1 = 46 * MiB, WS_WO1 = 62 * MiB;
constexpr size_t WS_WGU0 = 70 * MiB, WS_WD0 = 134 * MiB;
constexpr size_t WS_XB = 166 * MiB;
constexpr size_t WS_X1 = 230 * MiB;
constexpr size_t WS_HB = 294 * MiB;
constexpr size_t WS_MIX = 438 * MiB;
constexpr size_t WS_QB = 502 * MiB, WS_KB = 550 * MiB;
constexpr size_t WS_END = 598 * MiB;
constexpr size_t WS_VTB = WS_XB, WS_HM = WS_XB, WS_UPD = WS_X1, WS_PRE = WS_HB, WS_U = WS_HB, WS_VT1 = WS_HB + 64 * MiB, WS_YS = WS_HB, WS_EXTRA = WS_MIX;
constexpr size_t WS_WGU1 = WS_QB, WS_WD1 = WS_QB + 64 * MiB;
constexpr int CW_BAR = 4096;
constexpr int CW_CNT = 8192;
constexpr size_t CTL_RSQ = 256 * 1024, CTL_RSKV = 320 * 1024, CTL_VSUM = 384 * 1024, CTL_VSQ = 448 * 1024;

constexpr int RING_BYTES = 131072;
constexpr int MISC_OFF = RING_BYTES;
constexpr int LDS_BYTES = 147456;
constexpr int MW_BAR = 0, MW_TP = 16, MW_CNT = 48, MW_LCNT = 64, MW_LBASE = 80, MW_REC = 128;

#define RLX_AGENT __ATOMIC_RELAXED, __HIP_MEMORY_SCOPE_AGENT
#define LDS_WAIT() asm volatile("s_waitcnt lgkmcnt(0)" ::: "memory")
__device__ __forceinline__ unsigned pk2(float lo, float hi) { f32x2 v = {lo, hi}; bf16x2_t b = __builtin_convertvector(v, bf16x2_t); return __builtin_bit_cast(unsigned, b); }
__device__ __forceinline__ float bf2f(unsigned short u) { return __builtin_bit_cast(float, (unsigned)u << 16); }
__device__ __forceinline__ float bflo(unsigned u) { return __builtin_bit_cast(float, u << 16); }
__device__ __forceinline__ float bfhi(unsigned u) { return __builtin_bit_cast(float, u & 0xffff0000u); }
__device__ __forceinline__ float fast_exp2(float x) { return __builtin_amdgcn_exp2f(x); }
__device__ __forceinline__ float fast_rcp(float x) { return __builtin_amdgcn_rcpf(x); }
__device__ __forceinline__ float sigmoidf_(float x) { return fast_rcp(1.0f + fast_exp2(-1.4426950408889634f * x)); }
__device__ __forceinline__ float gelu_tanh(float x) { const float z = x * (1.5957691216057308f + 0.07135481627f * x * x); return x * sigmoidf_(z); }
__device__ __forceinline__ float wave_sum(float v) {
#pragma unroll
    for (int o = 1; o < 64; o <<= 1) v += __shfl_xor(v, o);
    return v;
}
__device__ __forceinline__ int fresh_tid() { int t = threadIdx.x; asm volatile("" : "+v"(t)); return t; }
#define MFMA32(a, b, c) __builtin_amdgcn_mfma_f32_32x32x16_bf16((a), (b), (c), 0, 0, 0)

#define XB_TMO      128
#define XB_XCNT(j)  (256  + 64 * (j))
#define XB_XSUB(j)  (1280 + 64 * (j))
#define XB_XGEN(j)  (2304 + 64 * (j))
#define XB_TOP      3328
#define XB_TOPGEN   3392
#define XCD_BAR_WORDS 3456
#define XB_SPIN_CAP (1u << 22)
__device__ __forceinline__ unsigned xb_ld(unsigned* p)              { return __hip_atomic_load(p, __ATOMIC_RELAXED, __HIP_MEMORY_SCOPE_AGENT); }
__device__ __forceinline__ unsigned xb_add(unsigned* p, unsigned v) { return __hip_atomic_fetch_add(p, v, __ATOMIC_RELAXED, __HIP_MEMORY_SCOPE_AGENT); }
__device__ __forceinline__ unsigned xb_xcc_id() { return (unsigned)__builtin_amdgcn_s_getreg((3 << 11) | 20) & 0xFu; }
#define XB_SPIN(cond, bar) do { unsigned _sp = 0; while (cond) { __builtin_amdgcn_s_sleep(1); \
    if ((++_sp & 255u) == 0u) { if (xb_ld(&(bar)[XB_TMO])) break; if (_sp > XB_SPIN_CAP) { atomicAdd(&(bar)[XB_TMO], 1u); break; } } } } while (0)
struct XcdBarrier { unsigned* bar; unsigned x; volatile LAS unsigned* st; };
__device__ __forceinline__ XcdBarrier xcd_barrier_post(unsigned* bar, volatile LAS unsigned* st) {
    XcdBarrier b; b.bar = bar; b.x = xb_xcc_id(); b.st = st;
    if (threadIdx.x == 0) (void)xb_add(&bar[XB_XCNT(b.x)], 1u);
    return b;
}
__device__ __forceinline__ void xcd_barrier_complete(unsigned* bar, unsigned x, unsigned& nloc, unsigned& nx) {
    const unsigned G = gridDim.x * gridDim.y * gridDim.z;
    unsigned sum, cnt, mine, sp = 0u;
    for (;;) {
        sum = 0u; cnt = 0u; mine = 0u;
#pragma unroll
        for (unsigned j = 0; j < 16; ++j) { const unsigned c = xb_ld(&bar[XB_XCNT(j)]); sum += c; cnt += (c > 0u) ? 1u : 0u; mine = (j == x) ? c : mine; }
        if (sum == G) break;
        __builtin_amdgcn_s_sleep(1);
        if ((++sp & 255u) == 0u) { if (xb_ld(&bar[XB_TMO])) break; if (sp > XB_SPIN_CAP) { atomicAdd(&bar[XB_TMO], 1u); break; } }
    }
    nloc = mine > 0u ? mine : 1u; nx = cnt > 0u ? cnt : 1u;
}
__device__ __forceinline__ void xcd_barrier(const XcdBarrier& b) {
    asm volatile("s_waitcnt vmcnt(0)" ::: "memory");
    __syncthreads();
    if (threadIdx.x == 0) {
        unsigned* bar = b.bar;
        __builtin_amdgcn_s_waitcnt(0);
        unsigned nloc = b.st[0], nx = b.st[1];
        if (nloc == 0u) { xcd_barrier_complete(bar, b.x, nloc, nx); b.st[0] = nloc; b.st[1] = nx; }
        const unsigned old = xb_add(&bar[XB_XSUB(b.x)], 1u);
        const unsigned gen = old / nloc;
        if (old + 1u == (gen + 1u) * nloc) {
            __builtin_amdgcn_fence(__ATOMIC_RELEASE, "agent");
            asm volatile("s_waitcnt vmcnt(0)" ::: "memory");
            const unsigned og = xb_add(&bar[XB_TOP], 1u);
            const unsigned tg = og / nx;
            if (og + 1u == (tg + 1u) * nx) xb_add(&bar[XB_TOPGEN], 1u);
            else XB_SPIN(xb_ld(&bar[XB_TOPGEN]) == tg, bar);
            __builtin_amdgcn_fence(__ATOMIC_ACQUIRE, "agent");
            xb_add(&bar[XB_XGEN(b.x)], 1u);
            asm volatile("s_waitcnt vmcnt(0)" ::: "memory");
        } else {
            XB_SPIN(xb_ld(&bar[XB_XGEN(b.x)]) == gen, bar);
            __builtin_amdgcn_fence(__ATOMIC_ACQUIRE, "agent");
            asm volatile("s_waitcnt vmcnt(0)" ::: "memory");
        }
    }
    __syncthreads();
}

namespace pg8 {
constexpr int BM = 256, BK = 64, HALF = 128, HTB = HALF * BK * 2, STAGE_BYTES = 8 * HTB, NXCD = 8, WGM = 8;
__device__ __forceinline__ int lds_byte(int r, int c) { const int st = (r >> 4) * 2 + (c >> 5), rr = r & 15, cc = c & 31, ob = rr * 64 + cc * 2; return st * 1024 + (ob ^ (((ob >> 9) & 1) << 5)); }
__device__ __forceinline__ void stage_rc(int b, int& R, int& C) { const int st = b / 1024, sb = b % 1024, swz = sb ^ (((sb >> 9) & 1) << 5); R = (st >> 1) * 16 + swz / 64; C = (st & 1) * 32 + (swz % 64) / 2; }
__device__ __forceinline__ int perm32(int rho) { const int n = rho >> 4, i = rho & 15; return 8 * (i >> 2) + 4 * n + (i & 3); }

struct Unit { int pm, pn, aux, aux2; const char* a; const char* b; };

__device__ __forceinline__ void tile_of(int L, int nM, int nN, int& pm, int& pn) {
    const int nwg = nM * nN; int wgid = L;
    { const int q = nwg / NXCD, r = nwg % NXCD, xcd = wgid % NXCD, off = wgid / NXCD; wgid = (xcd < r ? xcd * (q + 1) : r * (q + 1) + (xcd - r) * q) + off; }
    const int nig = WGM * nN, gid = wgid / nig, fm = gid * WGM, gsz = (nM - fm) < WGM ? (nM - fm) : WGM;
    pm = fm + ((wgid % nig) % gsz); pn = (wgid % nig) / gsz;
}
struct PlainOrder {
    int nM, nN, nwg, G, c, ksplit; const char* A; const char* Bt; size_t a_tile, b_tile; size_t kslice_bytes;
    __device__ __forceinline__ void init(const void* A_, const void* Bt_, int M, int N, int lda, int ldb, int G_, int c_, int ksplit_ = 1, int Kslice = 0) {
        nM = M / BM; nN = N / BM; nwg = nM * nN; G = G_; c = c_; ksplit = ksplit_; A = (const char*)A_; Bt = (const char*)Bt_;
        a_tile = (size_t)BM * lda * 2; b_tile = (size_t)BM * ldb * 2; kslice_bytes = (size_t)Kslice * 2; }
    __device__ __forceinline__ bool next(int i, Unit& u) const {
        const long L = (long)i * G + c; if (L >= (long)nwg * ksplit) return false;
        const int ks = (int)(L / nwg), Lt = (int)(L % nwg);
        tile_of(Lt, nM, nN, u.pm, u.pn); u.aux = ks; u.aux2 = 0;
        u.a = A + (size_t)u.pm * a_tile + (size_t)ks * kslice_bytes; u.b = Bt + (size_t)u.pn * b_tile + (size_t)ks * kslice_bytes; return true; }
    __device__ __forceinline__ unsigned row_off(const Unit&, int) const { return 0u; }
};

template <class Epi, class Sched, bool GATHER>
__device__ __forceinline__ void gemm_phase(LAS unsigned char* lds, const int K, const int lda, const int ldb, const Sched& S, const Epi& E) {
    const int tid = fresh_tid(), wid = __builtin_amdgcn_readfirstlane(tid >> 6), lane = tid & 63, wr = wid >> 2, wc = wid & 3, fr = lane & 15, fq = lane >> 4;
    const int nt = K / BK;
    unsigned voffB[2], cvA[2][2], nvA[2][2]; int Rr[2], C2 = 0;
#pragma unroll
    for (int i = 0; i < 2; ++i) { int R, C; stage_rc(tid * 16 + i * 8192, R, C); const int Rb = Epi::PERM ? ((R & ~31) + perm32(R & 31)) : R;
        voffB[i] = (unsigned)(Rb * ldb + C) * 2u; Rr[i] = R; C2 = C * 2; }
    const size_t kstep = (size_t)(BK * 2);
    const size_t hstepB = (size_t)HALF * ldb * 2;
    const unsigned ldsw = (unsigned)wid * 1024u;
    const int aoff = lds_byte(wr * 64 + fr, fq * 8), boff = lds_byte(wc * 32 + fr, fq * 8);
#define PG8_SA(b, h) (((b) * 2 + (h)) * HTB)
#define PG8_SB(b, h) ((4 + (b) * 2 + (h)) * HTB)
#define PG8_STAGE(bufoff, gbase, voff) do { _Pragma("unroll") for (int _i = 0; _i < 2; ++_i) \
        __builtin_amdgcn_global_load_lds((const unsigned*)((const char*)(gbase) + (voff)[_i]), (LAS unsigned*)(lds + (bufoff) + ldsw + _i * 8192), 16, 0, 0); } while (0)
#define PG8_LDA(dst, b, h) do { _Pragma("unroll") for (int m = 0; m < 4; ++m) _Pragma("unroll") for (int k = 0; k < 2; ++k) dst[m][k] = *(const LAS bf16x8*)(lds + PG8_SA(b, h) + aoff + m * 2048 + k * 1024); } while (0)
#define PG8_LDB(dst, b, h) do { _Pragma("unroll") for (int n = 0; n < 2; ++n) _Pragma("unroll") for (int k = 0; k < 2; ++k) dst[n][k] = *(const LAS bf16x8*)(lds + PG8_SB(b, h) + boff + n * 2048 + k * 1024); } while (0)
#define PG8_MMA(ai, bj, At, Bt) do { __builtin_amdgcn_s_setprio(1); _Pragma("unroll") for (int m = 0; m < 4; ++m) _Pragma("unroll") for (int n = 0; n < 2; ++n) _Pragma("unroll") for (int k = 0; k < 2; ++k) \
        acc[ai][bj][m][n] = __builtin_amdgcn_mfma_f32_16x16x32_bf16(Bt[n][k], At[m][k], acc[ai][bj][m][n], 0, 0, 0); __builtin_amdgcn_s_setprio(0); } while (0)
#define PG8_WAIT_V(n) asm volatile("s_waitcnt vmcnt(" #n ")" ::: "memory")
#define PG8_WAIT_L(n) asm volatile("s_waitcnt lgkmcnt(" #n ")" ::: "memory")
#define PG8_BAR __builtin_amdgcn_s_barrier()
#define PG8_SCHED __builtin_amdgcn_sched_barrier(0)
#define PG8_OFFS(v, u) do { _Pragma("unroll") for (int _h = 0; _h < 2; ++_h) _Pragma("unroll") for (int _i = 0; _i < 2; ++_i) { const int _r = _h * HALF + Rr[_i]; \
        (v)[_h][_i] = GATHER ? (S.row_off((u), _r) + (unsigned)C2) : ((unsigned)(_r * lda) * 2u + (unsigned)C2); } } while (0)
    Unit cur, nxt; int ui = 0;
    if (!S.next(0, cur)) return;
    f32x4 acc[2][2][4][2];
#pragma unroll
    for (int a = 0; a < 2; ++a)
#pragma unroll
        for (int b = 0; b < 2; ++b)
#pragma unroll
            for (int m = 0; m < 4; ++m)
#pragma unroll
                for (int n = 0; n < 2; ++n) acc[a][b][m][n] = (f32x4){0.f, 0.f, 0.f, 0.f};
    bf16x8 At[4][2], B0[2][2], B1[2][2];
    const char* cA = cur.a; const char* cB = cur.b;
    PG8_OFFS(cvA, cur);
    if (GATHER) { asm volatile("s_waitcnt vmcnt(0)" ::: "memory"); asm volatile("" : "+v"(cvA[0][0]), "+v"(cvA[0][1]), "+v"(cvA[1][0]), "+v"(cvA[1][1])); }
    PG8_STAGE(PG8_SB(0, 0), cB, voffB); PG8_STAGE(PG8_SB(0, 1), cB + hstepB, voffB); PG8_STAGE(PG8_SA(0, 0), cA, cvA[0]); PG8_STAGE(PG8_SA(0, 1), cA, cvA[1]);
    if (wr == 1) PG8_BAR;
    PG8_WAIT_V(2); PG8_BAR;
    PG8_STAGE(PG8_SB(1, 0), cB + kstep, voffB); PG8_STAGE(PG8_SA(1, 0), cA + kstep, cvA[0]); PG8_STAGE(PG8_SB(1, 1), cB + hstepB + kstep, voffB);
    PG8_WAIT_V(6); PG8_BAR;
    for (;;) {
        const bool has_next = S.next(ui + 1, nxt);
        const char* nA = has_next ? nxt.a : cA; const char* nB = has_next ? nxt.b : cB;
        if (GATHER) { if (has_next) { PG8_OFFS(nvA, nxt); asm volatile("s_waitcnt vmcnt(0)" ::: "memory"); asm volatile("" : "+v"(nvA[0][0]), "+v"(nvA[0][1]), "+v"(nvA[1][0]), "+v"(nvA[1][1])); } else {
#pragma unroll
            for (int h = 0; h < 2; ++h)
#pragma unroll
                for (int i = 0; i < 2; ++i) nvA[h][i] = cvA[h][i]; } }
        else {
#pragma unroll
            for (int h = 0; h < 2; ++h)
#pragma unroll
                for (int i = 0; i < 2; ++i) nvA[h][i] = cvA[h][i]; }
        for (int t = 0; t < nt; t += 2) {
            const bool last = (t == nt - 2);
            const char* a1 = cA + (size_t)(t + 1) * kstep;
            const char* a2 = last ? nA : cA + (size_t)(t + 2) * kstep; const char* b2 = last ? nB : cB + (size_t)(t + 2) * kstep;
            const char* a3 = a2 + kstep; const char* b3 = b2 + kstep;
            unsigned o0[2], o1[2];
#pragma unroll
            for (int i = 0; i < 2; ++i) { o0[i] = last ? nvA[0][i] : cvA[0][i]; o1[i] = last ? nvA[1][i] : cvA[1][i]; }
            PG8_LDB(B0, 0, 0); PG8_LDB(B1, 0, 1); PG8_SCHED; PG8_LDA(At, 0, 0); PG8_STAGE(PG8_SA(1, 1), a1, cvA[1]);
            PG8_WAIT_V(8); PG8_WAIT_L(0); PG8_BAR; PG8_MMA(0, 0, At, B0); PG8_MMA(0, 1, At, B1); PG8_BAR; PG8_SCHED;
            PG8_LDA(At, 0, 1); PG8_STAGE(PG8_SB(0, 0), b2, voffB); PG8_STAGE(PG8_SB(0, 1), b2 + hstepB, voffB); PG8_STAGE(PG8_SA(0, 0), a2, o0);
            PG8_WAIT_V(8); PG8_WAIT_L(0); PG8_BAR; PG8_MMA(1, 0, At, B0); PG8_MMA(1, 1, At, B1); PG8_BAR; PG8_SCHED;
            PG8_LDB(B0, 1, 0); PG8_LDB(B1, 1, 1); PG8_SCHED; PG8_LDA(At, 1, 0); PG8_STAGE(PG8_SA(0, 1), a2, o1);
            PG8_WAIT_V(8); PG8_WAIT_L(0); PG8_BAR; PG8_MMA(0, 0, At, B0); PG8_MMA(0, 1, At, B1); PG8_BAR; PG8_SCHED;
            PG8_LDA(At, 1, 1); PG8_STAGE(PG8_SB(1, 0), b3, voffB); PG8_STAGE(PG8_SB(1, 1), b3 + hstepB, voffB); PG8_STAGE(PG8_SA(1, 0), a3, o0);
            PG8_WAIT_V(8); PG8_WAIT_L(0); PG8_BAR; PG8_MMA(1, 0, At, B0); PG8_MMA(1, 1, At, B1); PG8_BAR; PG8_SCHED;
        }
        if (wr == 0) PG8_BAR;
        E(acc, cur, wr, wc, fr, fq);
        if (!has_next) break;
#pragma unroll
        for (int a = 0; a < 2; ++a)
#pragma unroll
            for (int b = 0; b < 2; ++b)
#pragma unroll
                for (int m = 0; m < 4; ++m)
#pragma unroll
                    for (int n = 0; n < 2; ++n) acc[a][b][m][n] = (f32x4){0.f, 0.f, 0.f, 0.f};
        cur = nxt; cA = nA; cB = nB; ++ui;
#pragma unroll
        for (int h = 0; h < 2; ++h)
#pragma unroll
            for (int i = 0; i < 2; ++i) cvA[h][i] = nvA[h][i];
        if (wr == 1) PG8_BAR;
    }
    PG8_WAIT_V(0);
    PG8_BAR;
#undef PG8_SA
#undef PG8_SB
#undef PG8_STAGE
#undef PG8_LDA
#undef PG8_LDB
#undef PG8_MMA
#undef PG8_WAIT_V
#undef PG8_WAIT_L
#undef PG8_BAR
#undef PG8_SCHED
#undef PG8_OFFS
}
}

typedef f32x4 AccT[2][2][4][2];
__device__ __forceinline__ u32x4 pack8(const f32x4 v0, const f32x4 v1) { u32x4 w; w.x = pk2(v0[0], v0[1]); w.y = pk2(v0[2], v0[3]); w.z = pk2(v1[0], v1[1]); w.w = pk2(v1[2], v1[3]); return w; }

struct EpiIn0 {
    static constexpr bool PERM = true;
    bf16* HB; float* rsq; float* rskv;
    __device__ __forceinline__ void operator()(const AccT& acc, const pg8::Unit& u, int wr, int wc, int fr, int fq) const {
        const int row0 = u.pm * 256 + wr * 64 + fr, col0 = u.pn * 256 + wc * 32 + 8 * fq;
        float* rs = (u.pn < 2) ? rsq : rskv; const int slot = (u.pn & 1) * 4 + wc;
#pragma unroll
        for (int ai = 0; ai < 2; ++ai)
#pragma unroll
            for (int m = 0; m < 4; ++m) { const int row = row0 + ai * 128 + m * 16; bf16* rowp = HB + (size_t)row * HBW + col0; float ss = 0.f;
#pragma unroll
                for (int bj = 0; bj < 2; ++bj) { const f32x4 v0 = acc[ai][bj][m][0], v1 = acc[ai][bj][m][1];
                    ss += (v0[0] * v0[0] + v0[1] * v0[1]) + (v0[2] * v0[2] + v0[3] * v0[3]) + (v1[0] * v1[0] + v1[1] * v1[1]) + (v1[2] * v1[2] + v1[3] * v1[3]);
                    *(u32x4*)(rowp + bj * 128) = pack8(v0, v1); }
                if (u.pn < 4) { ss += __shfl_xor(ss, 16); ss += __shfl_xor(ss, 32); if (fq == 0) rs[(size_t)row * 8 + slot] = ss; } }
    }
};
__device__ __forceinline__ float rs_from_parts(const float* part, int row) {
    const f32x4 a = *(const f32x4*)(part + (size_t)row * 8), b = *(const f32x4*)(part + (size_t)row * 8 + 4);
    return rsqrtf((((a[0] + a[1]) + (a[2] + a[3])) + ((b[0] + b[1]) + (b[2] + b[3]))) * (1.0f / 512.0f) + EPS);
}
struct EpiExtra {
    static constexpr bool PERM = false;
    float* EX;
    __device__ __forceinline__ void operator()(const AccT& acc, const pg8::Unit& u, int wr, int wc, int fr, int fq) const {
        const int row0 = u.pm * 256 + wr * 64 + fr;
        if (wc > 2) return;
#pragma unroll
        for (int ai = 0; ai < 2; ++ai)
#pragma unroll
            for (int m = 0; m < 4; ++m) { float* rowp = EX + ((size_t)u.aux * T + row0 + ai * 128 + m * 16) * 128 + wc * 32 + 4 * fq;
                *(f32x4*)(rowp) = acc[ai][0][m][0];
                if (wc < 2) *(f32x4*)(rowp + 16) = acc[ai][0][m][1]; }
    }
};
struct EpiQ {
    static constexpr bool PERM = true;
    bf16* QB; const float* rsq; const float* cs; const float* sn;
    __device__ __forceinline__ void operator()(const AccT& acc, const pg8::Unit& u, int wr, int wc, int fr, int fq) const {
        const int row0 = u.pm * 256 + wr * 64 + fr;
#pragma unroll
        for (int ai = 0; ai < 2; ++ai)
#pragma unroll
            for (int m = 0; m < 4; ++m) { const int row = row0 + ai * 128 + m * 16; const int b = row >> 13, s = row & 8191;
                const float rs = rs_from_parts(rsq, row);
                if (u.pn < 4) {
#pragma unroll
                    for (int bj = 0; bj < 2; ++bj) { const int head = u.pn * 2 + bj; bf16* p = QB + ((size_t)(b * NH + head) * SEQ + s) * DQK + wc * 32 + 8 * fq;
                        *(u32x4*)p = pack8(acc[ai][bj][m][0] * rs, acc[ai][bj][m][1] * rs); }
                } else {
                    const int head = (u.pn - 4) * 4 + wc; bf16* p = QB + ((size_t)(b * NH + head) * SEQ + s) * DQK + 128 + 8 * fq;
                    const f32x4 c0 = *(const f32x4*)(cs + (size_t)row * 32 + 8 * fq), c1 = *(const f32x4*)(cs + (size_t)row * 32 + 8 * fq + 4);
                    const f32x4 s0 = *(const f32x4*)(sn + (size_t)row * 32 + 8 * fq), s1 = *(const f32x4*)(sn + (size_t)row * 32 + 8 * fq + 4);
                    const f32x4 a0 = acc[ai][0][m][0] * rs, a1 = acc[ai][0][m][1] * rs, b0 = acc[ai][1][m][0] * rs, b1 = acc[ai][1][m][1] * rs;
                    *(u32x4*)p = pack8(a0 * c0 - b0 * s0, a1 * c1 - b1 * s1);
                    *(u32x4*)(p + 32) = pack8(b0 * c0 + a0 * s0, b1 * c1 + a1 * s1); }
            }
    }
};
struct EpiK {
    static constexpr bool PERM = true;
    bf16* KB; const float* rskv;
    __device__ __forceinline__ void operator()(const AccT& acc, const pg8::Unit& u, int wr, int wc, int fr, int fq) const {
        const int row0 = u.pm * 256 + wr * 64 + fr;
#pragma unroll
        for (int ai = 0; ai < 2; ++ai)
#pragma unroll
            for (int m = 0; m < 4; ++m) { const int row = row0 + ai * 128 + m * 16; const int b = row >> 13, s = row & 8191;
                const float rs = rs_from_parts(rskv, row);
#pragma unroll
                for (int bj = 0; bj < 2; ++bj) { const int head = u.pn * 2 + bj; bf16* p = KB + ((size_t)(b * NH + head) * SEQ + s) * DQK + wc * 32 + 8 * fq;
                    *(u32x4*)p = pack8(acc[ai][bj][m][0] * rs, acc[ai][bj][m][1] * rs); } }
    }
};
struct EpiVt {
    static constexpr bool PERM = true;
    bf16* VTB; const float* rskv;
    __device__ __forceinline__ void operator()(const AccT& acc, const pg8::Unit& u, int wr, int wc, int fr, int fq) const {
        const int f0 = u.pm * 256 + wr * 64 + fr, tok0 = u.pn * 256 + wc * 32 + 8 * fq;
        f32x4 sc[2][2];
#pragma unroll
        for (int bj = 0; bj < 2; ++bj)
#pragma unroll
            for (int n = 0; n < 2; ++n)
#pragma unroll
                for (int j = 0; j < 4; ++j) sc[bj][n][j] = rs_from_parts(rskv, tok0 + bj * 128 + 4 * n + j);
#pragma unroll
        for (int ai = 0; ai < 2; ++ai)
#pragma unroll
            for (int m = 0; m < 4; ++m) { const int f = f0 + ai * 128 + m * 16; const int h = f >> 7, dv = f & 127;
#pragma unroll
                for (int bj = 0; bj < 2; ++bj) { const int tok = tok0 + bj * 128; const int b = tok >> 13, s = tok & 8191;
                    bf16* p = VTB + ((size_t)(b * NH + h) * DV + dv) * SEQ + s;
                    *(u32x4*)p = pack8(acc[ai][bj][m][0] * sc[bj][0], acc[ai][bj][m][1] * sc[bj][1]); } }
    }
};
template <bool RES_BF16> struct EpiPre {
    static constexpr bool PERM = true;
    bf16* PRE; const float* resf; const bf16* resb;
    __device__ __forceinline__ void operator()(const AccT& acc, const pg8::Unit& u, int wr, int wc, int fr, int fq) const {
        const int row0 = u.pm * 256 + wr * 64 + fr, col0 = u.pn * 256 + wc * 32 + 8 * fq;
#pragma unroll
        for (int ai = 0; ai < 2; ++ai) { f32x4 r0[4][2], r1[4][2]; u32x4 q[4][2];
#pragma unroll
            for (int m = 0; m < 4; ++m)
#pragma unroll
                for (int bj = 0; bj < 2; ++bj) { const size_t o = (size_t)(row0 + ai * 128 + m * 16) * D + col0 + bj * 128;
                    if (RES_BF16) q[m][bj] = *(const u32x4*)(resb + o); else { r0[m][bj] = *(const f32x4*)(resf + o); r1[m][bj] = *(const f32x4*)(resf + o + 4); } }
            asm volatile("" ::: "memory");
#pragma unroll
            for (int m = 0; m < 4; ++m)
#pragma unroll
                for (int bj = 0; bj < 2; ++bj) { const size_t o = (size_t)(row0 + ai * 128 + m * 16) * D + col0 + bj * 128;
                    if (RES_BF16) { const u32x4 t = q[m][bj]; r0[m][bj] = (f32x4){bflo(t.x), bfhi(t.x), bflo(t.y), bfhi(t.y)}; r1[m][bj] = (f32x4){bflo(t.z), bfhi(t.z), bflo(t.w), bfhi(t.w)}; }
                    *(u32x4*)(PRE + o) = pack8(r0[m][bj] * ALPHA + acc[ai][bj][m][0], r1[m][bj] * ALPHA + acc[ai][bj][m][1]); } }
    }
};
struct EpiMoeUp {
    static constexpr bool PERM = true;
    bf16* HM;
    __device__ __forceinline__ void operator()(const AccT& acc, const pg8::Unit& u, int wr, int wc, int fr, int fq) const {
        const int row0 = u.aux2 + wr * 64 + fr, col0 = u.pn * 128 + wc * 32 + 8 * fq;
#pragma unroll
        for (int ai = 0; ai < 2; ++ai)
#pragma unroll
            for (int m = 0; m < 4; ++m) { bf16* p = HM + (size_t)(row0 + ai * 128 + m * 16) * DE + col0; f32x4 h[2];
#pragma unroll
                for (int n = 0; n < 2; ++n)
#pragma unroll
                    for (int j = 0; j < 4; ++j) { const float g = acc[ai][0][m][n][j]; h[n][j] = g * sigmoidf_(g) * acc[ai][1][m][n][j]; }
                *(u32x4*)p = pack8(h[0], h[1]); }
    }
};
struct EpiMoeDown {
    static constexpr bool PERM = true;
    bf16* YS;
    __device__ __forceinline__ void operator()(const AccT& acc, const pg8::Unit& u, int wr, int wc, int fr, int fq) const {
        const int row0 = u.aux2 + wr * 64 + fr, col0 = u.pn * 256 + wc * 32 + 8 * fq;
#pragma unroll
        for (int ai = 0; ai < 2; ++ai)
#pragma unroll
            for (int m = 0; m < 4; ++m) { bf16* p = YS + (size_t)(row0 + ai * 128 + m * 16) * D + col0;
#pragma unroll
                for (int bj = 0; bj < 2; ++bj) *(u32x4*)(p + bj * 128) = pack8(acc[ai][bj][m][0], acc[ai][bj][m][1]); }
    }
};
struct EpiU {
    static constexpr bool PERM = true;
    bf16* U;
    __device__ __forceinline__ void operator()(const AccT& acc, const pg8::Unit& u, int wr, int wc, int fr, int fq) const {
        const int row0 = u.pm * 256 + wr * 64 + fr, col0 = u.pn * 256 + wc * 32 + 8 * fq;
#pragma unroll
        for (int ai = 0; ai < 2; ++ai)
#pragma unroll
            for (int m = 0; m < 4; ++m) { bf16* p = U + (size_t)(row0 + ai * 128 + m * 16) * D + col0;
#pragma unroll
                for (int bj = 0; bj < 2; ++bj) { f32x4 v0 = acc[ai][bj][m][0], v1 = acc[ai][bj][m][1];
#pragma unroll
                    for (int j = 0; j < 4; ++j) { v0[j] = gelu_tanh(v0[j]); v1[j] = gelu_tanh(v1[j]); }
                    *(u32x4*)(p + bj * 128) = pack8(v0, v1); } }
    }
};
struct EpiVT1 {
    static constexpr bool PERM = true;
    bf16* VT; float* vsum; float* vsq;
    __device__ __forceinline__ void operator()(const AccT& acc, const pg8::Unit& u, int wr, int wc, int fr, int fq) const {
        const int ch0 = u.pm * 256 + wr * 64 + fr, tok0 = u.pn * 256 + wc * 32 + 8 * fq;
        f32x4 s1[2][2], s2[2][2];
#pragma unroll
        for (int bj = 0; bj < 2; ++bj)
#pragma unroll
            for (int n = 0; n < 2; ++n) { s1[bj][n] = (f32x4){0.f, 0.f, 0.f, 0.f}; s2[bj][n] = (f32x4){0.f, 0.f, 0.f, 0.f}; }
#pragma unroll
        for (int ai = 0; ai < 2; ++ai)
#pragma unroll
            for (int m = 0; m < 4; ++m) { bf16* p = VT + (size_t)(ch0 + ai * 128 + m * 16) * T + tok0;
#pragma unroll
                for (int bj = 0; bj < 2; ++bj) { f32x4 v0 = acc[ai][bj][m][0], v1 = acc[ai][bj][m][1];
#pragma unroll
                    for (int j = 0; j < 4; ++j) { v0[j] = gelu_tanh(v0[j]); v1[j] = gelu_tanh(v1[j]); }
                    s1[bj][0] += v0; s1[bj][1] += v1; s2[bj][0] += v0 * v0; s2[bj][1] += v1 * v1;
                    *(u32x4*)(p + bj * 128) = pack8(v0, v1); } }
#pragma unroll
        for (int bj = 0; bj < 2; ++bj)
#pragma unroll
            for (int n = 0; n < 2; ++n)
#pragma unroll
                for (int j = 0; j < 4; ++j) { float a = s1[bj][n][j], b = s2[bj][n][j];
#pragma unroll
                    for (int o = 1; o < 16; o <<= 1) { a += __shfl_xor(a, o); b += __shfl_xor(b, o); }
                    if (fr == 0) { const int tok = tok0 + bj * 128 + 4 * n + j; vsum[(size_t)tok * 16 + u.pm * 2 + wr] = a; vsq[(size_t)tok * 16 + u.pm * 2 + wr] = b; } }
    }
};

struct Args { const void* in[26]; float* out; unsigned char* ws; };
struct Frame {
    LAS unsigned char* lds; volatile LAS unsigned* MISC;
    int vcu;
    unsigned char* ws; gu32* ctl;
};
#define PH_IDS() const int tid = fresh_tid(), lane = tid & 63, wave = __builtin_amdgcn_readfirstlane(tid >> 6); (void)lane; (void)wave
#define WSP(T_, off) ((T_*)(F.ws + (off)))

__device__ __forceinline__ void cvt_item(const float* src, int ldsrc, int scol0, int nvalid, bf16* dst, int ldk, int drow0, int k0, const float* ks, float sc, LAS float* scr, int lane) {
    const int n = lane & 31; float t[32];
    const float* sp = src + (size_t)(k0 + (lane >> 5)) * ldsrc + scol0 + n;
    if (n < nvalid) {
#pragma unroll
        for (int i = 0; i < 32; ++i) t[i] = __builtin_nontemporal_load(sp + (size_t)(2 * i) * ldsrc);
        if (ks) {
#pragma unroll
            for (int i = 0; i < 32; ++i) t[i] *= ks[k0 + 2 * i + (lane >> 5)];
        }
    } else {
#pragma unroll
        for (int i = 0; i < 32; ++i) t[i] = 0.f;
    }
#pragma unroll
    for (int i = 0; i < 32; ++i) scr[(2 * i + (lane >> 5)) * 33 + n] = t[i] * sc;
    LDS_WAIT(); asm volatile("" ::: "memory");
    const int c = lane & 7;
#pragma unroll
    for (int j = 0; j < 4; ++j) { const int nn = (lane >> 3) + 8 * j; const LAS float* s = scr + (8 * c) * 33 + nn;
        u32x4 o; o.x = pk2(s[0 * 33], s[1 * 33]); o.y = pk2(s[2 * 33], s[3 * 33]); o.z = pk2(s[4 * 33], s[5 * 33]); o.w = pk2(s[6 * 33], s[7 * 33]);
        *(u32x4*)(dst + (size_t)(drow0 + nn) * ldk + k0 + 8 * c) = o; }
    LDS_WAIT(); asm volatile("" ::: "memory");
}
constexpr int MOE_CVT_SPLIT = 19660;
__device__ __forceinline__ void cvt_moe_layer(Frame& F, const float* wg, const float* wu, const float* wd, bf16* WGU, bf16* WD, int first_blk = 0, int it_lo = 0, int it_hi = 16 * 32 * 32 + 16 * 8 * 64) {
    PH_IDS();
    LAS float* scr = (LAS float*)(F.lds + wave * 16384);
    constexpr int I_GU = 16 * 32 * 32, I_D = 16 * 8 * 64;
    const int gw = ((first_blk ? (int)blockIdx.x - first_blk : F.vcu)) * NWAVES + wave, ngw = (GRID - first_blk) * NWAVES;
    for (int it = it_lo + gw; it < it_hi; it += ngw) {
        if (it < I_GU) { const int e = it >> 10, r = it & 1023, kb = r >> 5, nb = r & 31, p0 = 32 * nb, pn = p0 >> 8, sel = (p0 >> 7) & 1, c = p0 & 127;
            cvt_item((sel ? wu : wg) + (size_t)e * D * DE, DE, 128 * pn + c, 32, WGU + (size_t)e * 1024 * D, D, p0, 64 * kb, nullptr, 1.f, scr, lane); }
        else { const int q = it - I_GU, e = q >> 9, r = q & 511, kb = r >> 6, nb = r & 63;
            cvt_item(wd + (size_t)e * DE * D, D, 32 * nb, 32, WD + (size_t)e * D * DE, DE, 32 * nb, 64 * kb, nullptr, 1.f, scr, lane); }
    }
}
struct BgItem { const float* sp; bf16* dp; int ldsrc, ldk; };
__device__ __forceinline__ BgItem bg_moe_item(int it, const float* wg, const float* wu, const float* wd, bf16* WGU, bf16* WD, int lane) {
    constexpr int I_GU = 16 * 32 * 32; BgItem b; const float* src; bf16* dst; int scol0, drow0, k0;
    if (it < I_GU) { const int e = it >> 10, r = it & 1023, kb = r >> 5, nb = r & 31, p0 = 32 * nb, pn = p0 >> 8, sel = (p0 >> 7) & 1, c = p0 & 127;
        src = (sel ? wu : wg) + (size_t)e * D * DE; b.ldsrc = DE; scol0 = 128 * pn + c; dst = WGU + (size_t)e * 1024 * D; b.ldk = D; drow0 = p0; k0 = 64 * kb; }
    else { const int q = it - I_GU, e = q >> 9, r = q & 511, kb = r >> 6, nb = r & 63;
        src = wd + (size_t)e * DE * D; b.ldsrc = D; scol0 = 32 * nb; dst = WD + (size_t)e * D * DE; b.ldk = DE; drow0 = 32 * nb; k0 = 64 * kb; }
    b.sp = src + (size_t)(k0 + (lane >> 3)) * b.ldsrc + scol0 + 4 * (lane & 7); b.dp = dst + (size_t)drow0 * b.ldk + k0;
    return b;
}
constexpr int BG_P = 72, BG_SCR = 32 * BG_P * 2;
#define BG_PUT(t_, scr_, lane_, q_) do { LAS unsigned short* w_ = (scr_) + (4 * ((lane_) & 7)) * BG_P + 8 * (q_) + ((lane_) >> 3); const unsigned a_ = pk2(t_[0], t_[1]), b_ = pk2(t_[2], t_[3]); \
        w_[0] = (unsigned short)a_; w_[BG_P] = (unsigned short)(a_ >> 16); w_[2 * BG_P] = (unsigned short)b_; w_[3 * BG_P] = (unsigned short)(b_ >> 16); } while (0)
#define BG_STORE(b_, scr_, lane_) do { \
        LDS_WAIT(); asm volatile("" ::: "memory"); \
        _Pragma("unroll") for (int j_ = 0; j_ < 4; ++j_) { const int nn_ = ((lane_) >> 3) + 8 * j_; \
            *(u32x4*)((b_).dp + (size_t)nn_ * (b_).ldk + 8 * ((lane_) & 7)) = *(const LAS u32x4*)((scr_) + nn_ * BG_P + 8 * ((lane_) & 7)); } \
        LDS_WAIT(); asm volatile("" ::: "memory"); } while (0)
constexpr int BG_MOE_ITEMS = 16 * 32 * 32 + 16 * 8 * 64;
__device__ const double INV_FREQ[32] = {
    1.0, 0.7498942093324559, 0.5623413251903491, 0.4216965034285822, 0.31622776601683794, 0.23713737056616552, 0.1778279410038923, 0.1333521432163324,
    0.1, 0.07498942093324558, 0.05623413251903491, 0.04216965034285822, 0.03162277660168379, 0.023713737056616554, 0.01778279410038923, 0.01333521432163324,
    0.01, 0.007498942093324558, 0.005623413251903491, 0.004216965034285823, 0.0031622776601683794, 0.0023713737056616554, 0.0017782794100389228, 0.001333521432163324,
    0.001, 0.0007498942093324559, 0.0005623413251903491, 0.00042169650342858224, 0.00031622776601683794, 0.00023713737056616554, 0.00017782794100389227, 0.0001333521432163324};
__device__ __forceinline__ void sincos_d(double a, float& s, float& c) {
    const double q = __builtin_rint(a * 0.63661977236758134308);
    double r = __builtin_fma(-q, 1.57079632679489655800e+00, a); r = __builtin_fma(-q, 6.12323399573676603587e-17, r);
    const double r2 = r * r;
    double sp = -2.50521083854417187751e-08; sp = sp * r2 + 2.75573192239858906526e-06; sp = sp * r2 - 1.98412698412698412698e-04; sp = sp * r2 + 8.33333333333333333333e-03; sp = sp * r2 - 1.66666666666666666667e-01;
    const double sn = r + r * r2 * sp;
    double cp = 2.08767569878680989792e-09; cp = cp * r2 - 2.75573192239858906526e-07; cp = cp * r2 + 2.48015873015873015873e-05; cp = cp * r2 - 1.38888888888888888889e-03; cp = cp * r2 + 4.16666666666666666667e-02; cp = cp * r2 - 0.5;
    const double cn = 1.0 + r2 * cp;
    const int qi = (int)((long long)q & 3);
    const double ss = (qi == 0) ? sn : (qi == 1) ? cn : (qi == 2) ? -sn : -cn;
    const double cc = (qi == 0) ? cn : (qi == 1) ? -sn : (qi == 2) ? -cn : sn;
    s = (float)ss; c = (float)cc;
}
__device__ __forceinline__ void p0_prologue(Frame& F, const Args& A) {
    PH_IDS();
    LAS float* scr = (LAS float*)(F.lds + wave * 16384);
    const int gw = F.vcu * NWAVES + wave, NGW = GRID * NWAVES;
    const float* ev_w_in = (const float*)A.in[2]; const float* ev_q_norm = (const float*)A.in[3]; const float* ev_kv_norm = (const float*)A.in[4];
    const float* ev_w_uq = (const float*)A.in[5]; const float* ev_w_ukv = (const float*)A.in[6]; const float* ev_w_out = (const float*)A.in[10];
    const float* od_w_in = (const float*)A.in[11]; const float* od_w_out = (const float*)A.in[16];
    constexpr int I_IN0 = 32 * 128, I_X0 = 32 * 8, I_UQ = 8 * 48, I_UK = 8 * 32, I_UV = 8 * 32, I_O0 = 32 * 64, I_IN1 = 32 * 128, I_O1 = 32 * 64;
    constexpr int NIT = I_IN0 + I_X0 + I_UQ + I_UK + I_UV + I_O0 + I_IN1 + I_O1;
    for (int it = gw; it < NIT; it += NGW) {
        int r = it; const float* src; int ldsrc, scol0, nvalid = 32, ldk, drow0, k0; bf16* dst; const float* ks = nullptr; float sc = 1.f;
        if (r < I_IN0) { const int kb = r >> 7, nb = r & 127, p0 = 32 * nb; src = ev_w_in; ldsrc = 4176; scol0 = p0 < 1024 ? p0 : (p0 < 3072 ? p0 + 64 : p0 + 80); dst = WSP(bf16, WS_WIN0); ldk = D; drow0 = p0; k0 = 64 * kb; }
        else if ((r -= I_IN0) < I_X0) { const int kb = r >> 3, nb = r & 7, p0 = 32 * nb; src = ev_w_in; ldsrc = 4176; scol0 = nb < 2 ? 1024 + p0 : 3136; nvalid = nb < 2 ? 32 : (nb == 2 ? 16 : 0); dst = WSP(bf16, WS_WX0); ldk = D; drow0 = p0; k0 = 64 * kb; }
        else if ((r -= I_X0) < I_UQ) { const int kb = r / 48, nb = r % 48, p0 = 32 * nb; src = ev_w_uq; ldsrc = 1536; ks = ev_q_norm; sc = QSCALE;
            if (p0 < 1024) scol0 = (p0 >> 7) * 192 + (p0 & 127); else { const int q = p0 - 1024, tt = q >> 8, bj = (q >> 7) & 1, hl = (q >> 5) & 3; scol0 = (4 * tt + hl) * 192 + 128 + 32 * bj; }
            dst = WSP(bf16, WS_WUQ); ldk = 512; drow0 = p0; k0 = 64 * kb; }
        else if ((r -= I_UQ) < I_UK) { const int kb = r >> 5, nb = r & 31, p0 = 32 * nb; src = ev_w_ukv; ldsrc = 2048; ks = ev_kv_norm; scol0 = (p0 >> 7) * 256 + (p0 & 127); dst = WSP(bf16, WS_WUK); ldk = 512; drow0 = p0; k0 = 64 * kb; }
        else if ((r -= I_UK) < I_UV) { const int kb = r >> 5, nb = r & 31, p0 = 32 * nb; src = ev_w_ukv; ldsrc = 2048; ks = ev_kv_norm; scol0 = (p0 >> 7) * 256 + 128 + (p0 & 127); dst = WSP(bf16, WS_WUV); ldk = 512; drow0 = p0; k0 = 64 * kb; }
        else if ((r -= I_UV) < I_O0) { const int kb = r >> 6, nb = r & 63; src = ev_w_out; ldsrc = D; scol0 = 32 * nb; dst = WSP(bf16, WS_WO0); ldk = D; drow0 = 32 * nb; k0 = 64 * kb; }
        else if ((r -= I_O0) < I_IN1) { const int kb = r >> 7, nb = r & 127; src = od_w_in; ldsrc = 4096; scol0 = 32 * nb; dst = WSP(bf16, WS_WIN1); ldk = D; drow0 = 32 * nb; k0 = 64 * kb; }
        else { r -= I_IN1; const int kb = r >> 6, nb = r & 63; src = od_w_out; ldsrc = D; scol0 = 32 * nb; dst = WSP(bf16, WS_WO1); ldk = D; drow0 = 32 * nb; k0 = 64 * kb; }
        cvt_item(src, ldsrc, scol0, nvalid, dst, ldk, drow0, k0, ks, sc, scr, lane);
    }
    { const float* x = (const float*)A.in[0]; bf16* XB = WSP(bf16, WS_XB);
      for (size_t i = (size_t)blockIdx.x * NTHR + tid; i < (size_t)T * D / 8; i += (size_t)GRID * NTHR) {
          const f32x4 a = __builtin_nontemporal_load((const f32x4*)(x + i * 8)), b = __builtin_nontemporal_load((const f32x4*)(x + i * 8 + 4)); *(u32x4*)(XB + i * 8) = pack8(a, b); } }
    { const int* pos = (const int*)A.in[1]; float* cs = WSP(float, WS_COS); float* sn = WSP(float, WS_SIN);
      for (int i = blockIdx.x * NTHR + tid; i < T * 32; i += GRID * NTHR) { float s, c; sincos_d((double)pos[i >> 5] * INV_FREQ[i & 31], s, c); cs[i] = c; sn[i] = s; } }
    { const float* w_s = (const float*)A.in[14]; bf16* WS_ = WSP(bf16, WS_WS); float* wsum = WSP(float, WS_WSUM);
      for (int i = blockIdx.x * NTHR + tid; i < 16 * 128 * 128; i += GRID * NTHR) { const int ii = (i >> 7) & 127, j = i & 127; const float v = ((j >> 6) <= (ii >> 6)) ? w_s[i] : 0.f; WS_[i] = (bf16)(pk2(v, 0.f) & 0xffffu); }
      for (int i = blockIdx.x * NTHR + tid; i < 16 * 128; i += GRID * NTHR) { const int ii = i & 127; float s = 0.f; const int jn = (ii >> 6) ? 128 : 64; for (int j = 0; j < jn; ++j) s += w_s[(size_t)i * 128 + j]; wsum[i] = s; } }
}

__device__ __forceinline__ void krot_phase(Frame& F) {
    const float* EX = WSP(float, WS_EXTRA); const float* cs = WSP(float, WS_COS); const float* sn = WSP(float, WS_SIN); bf16* KB = WSP(bf16, WS_KB);
    PH_IDS();
    for (int idx = blockIdx.x * NTHR + tid; idx < T * 32; idx += GRID * NTHR) {
        const int t = idx >> 5, i = idx & 31; float x1 = 0.f, x2 = 0.f;
#pragma unroll
        for (int kq = 0; kq < 4; ++kq) { x1 += EX[((size_t)kq * T + t) * 128 + i]; x2 += EX[((size_t)kq * T + t) * 128 + 32 + i]; }
        const float c = cs[idx], s = sn[idx];
        const unsigned short o1 = (unsigned short)(pk2(x1 * c - x2 * s, 0.f) & 0xffffu), o2 = (unsigned short)(pk2(x2 * c + x1 * s, 0.f) & 0xffffu);
        const int b = t >> 13, sq = t & 8191;
#pragma unroll
        for (int h = 0; h < NH; ++h) { bf16* p = KB + ((size_t)(b * NH + h) * SEQ + sq) * DQK + 128 + i; p[0] = o1; p[32] = o2; }
    }
}

__device__ __forceinline__ void gla_upd_phase(Frame& F, const float* w_gk2, const float* b_gk2) {
    const bf16* HB = WSP(bf16, WS_HB); const float* EX = WSP(float, WS_EXTRA); bf16* UPD = WSP(bf16, WS_UPD); float* DEC = WSP(float, WS_DEC);
    LAS float* glr = (LAS float*)(F.lds);
    LAS float* tot = (LAS float*)(F.lds + 4096);
    LAS bf16* kdT = (LAS bf16*)(F.lds + 8192);
    LAS bf16* vT = (LAS bf16*)(F.lds + 26624);
    LAS bf16* ot = (LAS bf16*)(F.lds + 63488);
    PH_IDS(); const int w = wave, r = lane & 31, hh = lane >> 5;
    const int h = F.vcu & 3;
    const int dk = tid & 127, pg = tid >> 7, dvv = tid & 255, hf = tid >> 8;
    float wv[16];
#pragma unroll
    for (int rr = 0; rr < 16; ++rr) wv[rr] = w_gk2[rr * 512 + h * 128 + dk];
    const float bias = b_gk2[h * 128 + dk];
    float exr[8]; unsigned short vraw[32], kraw[16];
#define G1_LOAD(u_) do { const int bc_ = (u_) >> 2, t0_ = (bc_ >> 7) * SEQ + (bc_ & 127) * 64; \
        _Pragma("unroll") for (int k = 0; k < 2; ++k) { const int idx = tid + 512 * k, pos = idx >> 4, rr = idx & 15; \
            _Pragma("unroll") for (int kq = 0; kq < 4; ++kq) exr[4 * k + kq] = EX[((size_t)kq * T + t0_ + pos) * 128 + 64 + rr]; } \
        _Pragma("unroll") for (int p = 0; p < 32; ++p) vraw[p] = HB[(size_t)(t0_ + hf * 32 + p) * HBW + COL_GV + h * 256 + dvv]; \
        _Pragma("unroll") for (int p = 0; p < 16; ++p) kraw[p] = HB[(size_t)(t0_ + pg * 16 + p) * HBW + COL_GK + h * 128 + dk]; } while (0)
    if (F.vcu < 1024) G1_LOAD(F.vcu);
    for (int u = F.vcu; u < 1024; u += GRID) {
#pragma unroll
        for (int k = 0; k < 2; ++k) glr[tid + 512 * k] = (exr[4 * k] + exr[4 * k + 1]) + (exr[4 * k + 2] + exr[4 * k + 3]);
#pragma unroll
        for (int q = 0; q < 4; ++q) { u32x4 o; o.x = (unsigned)vraw[8 * q] | ((unsigned)vraw[8 * q + 1] << 16); o.y = (unsigned)vraw[8 * q + 2] | ((unsigned)vraw[8 * q + 3] << 16);
            o.z = (unsigned)vraw[8 * q + 4] | ((unsigned)vraw[8 * q + 5] << 16); o.w = (unsigned)vraw[8 * q + 6] | ((unsigned)vraw[8 * q + 7] << 16);
            *(LAS u32x4*)(vT + dvv * 72 + hf * 32 + 8 * q) = o; }
        __syncthreads();
        { float cum[16], run = 0.f;
#pragma unroll
          for (int p = 0; p < 16; ++p) { const int pos = pg * 16 + p; float lg = bias;
#pragma unroll
              for (int rr = 0; rr < 16; ++rr) lg += glr[pos * 16 + rr] * wv[rr];
              const float ls = fminf(lg, 0.f) - __logf(1.0f + __expf(-fabsf(lg)));
              run += ls * (1.0f / 16.0f); cum[p] = run; }
          tot[pg * 128 + dk] = run;
          __syncthreads();
          float off = 0.f, total = 0.f;
#pragma unroll
          for (int g = 0; g < 4; ++g) { const float tv = tot[g * 128 + dk]; total += tv; if (g < pg) off += tv; }
          unsigned pk[8];
#pragma unroll
          for (int p = 0; p < 8; ++p) pk[p] = pk2(bf2f(kraw[2 * p]) * __expf(total - (cum[2 * p] + off)), bf2f(kraw[2 * p + 1]) * __expf(total - (cum[2 * p + 1] + off)));
          *(LAS u32x4*)(kdT + dk * 72 + pg * 16) = (u32x4){pk[0], pk[1], pk[2], pk[3]};
          *(LAS u32x4*)(kdT + dk * 72 + pg * 16 + 8) = (u32x4){pk[4], pk[5], pk[6], pk[7]};
          if (pg == 0) DEC[(size_t)u * 128 + dk] = __expf(total); }
        if (u + GRID < 1024) G1_LOAD(u + GRID);
        __syncthreads();
        f32x16 acc[4];
#pragma unroll
        for (int db = 0; db < 4; ++db)
#pragma unroll
            for (int i = 0; i < 16; ++i) acc[db][i] = 0.f;
#pragma unroll
        for (int ks = 0; ks < 4; ++ks) { const bf16x8 bf = *(const LAS bf16x8*)(vT + (32 * w + r) * 72 + 16 * ks + 8 * hh); bf16x8 af[4];
#pragma unroll
            for (int db = 0; db < 4; ++db) af[db] = *(const LAS bf16x8*)(kdT + (32 * db + r) * 72 + 16 * ks + 8 * hh);
            __builtin_amdgcn_sched_barrier(0);
#pragma unroll
            for (int db = 0; db < 4; ++db) acc[db] = MFMA32(af[db], bf, acc[db]);
            __builtin_amdgcn_sched_barrier(0); }
        { LAS bf16* orow = ot + (32 * w + r) * 132;
#pragma unroll
          for (int db = 0; db < 4; ++db)
#pragma unroll
              for (int g = 0; g < 4; ++g) *(LAS u32x2*)(orow + 32 * db + 8 * g + 4 * hh) = (u32x2){pk2(acc[db][4 * g], acc[db][4 * g + 1]), pk2(acc[db][4 * g + 2], acc[db][4 * g + 3])}; }
        __syncthreads();
        { bf16* base = UPD + (size_t)u * 32768;
#pragma unroll
          for (int ps = 0; ps < 8; ++ps) { const int row = (tid >> 4) + 32 * ps, c = tid & 15; const LAS unsigned char* sp_ = (const LAS unsigned char*)(ot + row * 132) + c * 16;
              const u32x2 lo = *(const LAS u32x2*)sp_, hi = *(const LAS u32x2*)(sp_ + 8);
              *(u32x4*)(base + (size_t)row * 128 + c * 8) = (u32x4){lo.x, lo.y, hi.x, hi.y}; } }
    }
#undef G1_LOAD
}

__device__ __forceinline__ void gla_scan_phase(Frame& F) {
    bf16* UPD = WSP(bf16, WS_UPD); const float* DEC = WSP(float, WS_DEC);
    PH_IDS();
    if (tid >= 256) return;
    const int gt = blockIdx.x * 256 + tid;
    const int bh = gt >> 13, e4 = (gt & 8191) * 4, b = bh >> 2, h = bh & 3, dk = e4 & 127;
    f32x4 st = (f32x4){0.f, 0.f, 0.f, 0.f};
    for (int c0 = 0; c0 < 128; c0 += 16) {
        u32x2 uv[16]; f32x4 dv[16];
#pragma unroll
        for (int k = 0; k < 16; ++k) { const size_t u = (size_t)((b * 128 + c0 + k) * 4 + h); uv[k] = *(const u32x2*)(UPD + u * 32768 + e4); dv[k] = *(const f32x4*)(DEC + u * 128 + dk); }
#pragma unroll
        for (int k = 0; k < 16; ++k) { const size_t u = (size_t)((b * 128 + c0 + k) * 4 + h);
            const f32x4 up = (f32x4){bflo(uv[k].x), bfhi(uv[k].x), bflo(uv[k].y), bfhi(uv[k].y)};
            st = dv[k] * st + up;
            *(u32x2*)(UPD + u * 32768 + e4) = (u32x2){pk2(st[0], st[1]), pk2(st[2], st[3])}; }
    }
}

__device__ __forceinline__ void gla_out_phase(Frame& F, const float* g_norm) {
    const bf16* HB = WSP(bf16, WS_HB); const bf16* ST = WSP(bf16, WS_UPD); bf16* MIX = WSP(bf16, WS_MIX);
    LAS float* part = (LAS float*)(F.lds);
    LAS bf16* ql = (LAS bf16*)(F.lds + 2048);
    constexpr int QP = 136, GP = 264;
    LAS bf16* Gl = (LAS bf16*)(F.lds + 2048 + 64 * QP * 2);
    LAS bf16* Ol = (LAS bf16*)(F.lds + 2048 + 64 * QP * 2 + 64 * GP * 2);
    PH_IDS(); const int w = wave, r = lane & 31, hh = lane >> 5;
    bf16x8 af[8], afn[8]; u32x4 qs[2], qsn[2], gr[4], grn[4];
#define GO_LOAD(A_, Q_, G_, u_) do { const int h_ = (u_) & 3, bc_ = (u_) >> 2, t0_ = (bc_ >> 7) * SEQ + (bc_ & 127) * 64; \
        const bf16* ar_ = ST + (size_t)(u_) * 32768 + (size_t)(32 * w + r) * 128 + 64 * hh; \
        _Pragma("unroll") for (int ks = 0; ks < 8; ++ks) A_[ks] = *(const bf16x8*)(ar_ + 8 * ks); \
        _Pragma("unroll") for (int k = 0; k < 2; ++k) { const int c = tid + 512 * k, pos = c >> 4, cc = c & 15; Q_[k] = *(const u32x4*)(HB + (size_t)(t0_ + pos) * HBW + COL_GQ + h_ * 128 + cc * 8); } \
        _Pragma("unroll") for (int k = 0; k < 4; ++k) { const int c = tid + 512 * k, pos = c >> 5, cc = c & 31; G_[k] = *(const u32x4*)(HB + (size_t)(t0_ + pos) * HBW + COL_GO + h_ * 256 + cc * 8); } } while (0)
    if (F.vcu < 1024) GO_LOAD(af, qs, gr, F.vcu);
    for (int u = F.vcu; u < 1024; u += GRID) {
        const int h = u & 3, bc = u >> 2, t0 = (bc >> 7) * SEQ + (bc & 127) * 64;
#pragma unroll
        for (int k = 0; k < 2; ++k) { const int c = tid + 512 * k, pos = c >> 4, cc = c & 15; *(LAS u32x4*)(ql + pos * QP + cc * 8) = qs[k]; }
#pragma unroll
        for (int k = 0; k < 4; ++k) { const int c = tid + 512 * k, pos = c >> 5, cc = c & 31; *(LAS u32x4*)(Gl + pos * GP + cc * 8) = gr[k]; }
        __syncthreads();
        if (u + GRID < 1024) GO_LOAD(afn, qsn, grn, u + GRID);
        f32x16 acc[2];
#pragma unroll
        for (int pb = 0; pb < 2; ++pb)
#pragma unroll
            for (int i = 0; i < 16; ++i) acc[pb][i] = 0.f;
#pragma unroll
        for (int pb = 0; pb < 2; ++pb) { bf16x8 bq[8];
#pragma unroll
            for (int ks = 0; ks < 8; ++ks) bq[ks] = *(const LAS bf16x8*)(ql + (32 * pb + r) * QP + 64 * hh + 8 * ks);
            __builtin_amdgcn_sched_barrier(0);
#pragma unroll
            for (int ks = 0; ks < 8; ++ks) acc[pb] = MFMA32(af[ks], bq[ks], acc[pb]);
            __builtin_amdgcn_sched_barrier(0); }
        const float qsc = 0.08838834764831845f;
#pragma unroll
        for (int pb = 0; pb < 2; ++pb) { float ss = 0.f;
#pragma unroll
            for (int i = 0; i < 16; ++i) { acc[pb][i] *= qsc; ss += acc[pb][i] * acc[pb][i]; }
            ss += __shfl_xor(ss, 32);
            if (hh == 0) part[w * 64 + 32 * pb + r] = ss; }
        __syncthreads();
#pragma unroll
        for (int pb = 0; pb < 2; ++pb) { const int pos = 32 * pb + r; float ss = 0.f;
#pragma unroll
            for (int ww = 0; ww < 8; ++ww) ss += part[ww * 64 + pos];
            const float rs = rsqrtf(ss * (1.0f / 256.0f) + EPS);
#pragma unroll
            for (int g = 0; g < 4; ++g) { const int dv0 = 32 * w + 8 * g + 4 * hh;
                const u32x2 gq = *(const LAS u32x2*)(Gl + pos * GP + dv0);
                const f32x4 gn = *(const f32x4*)(g_norm + dv0);
                const float g0 = bflo(gq.x), g1 = bfhi(gq.x), g2 = bflo(gq.y), g3 = bfhi(gq.y);
                const float o0 = acc[pb][4 * g] * rs * gn[0] * (g0 * sigmoidf_(g0)), o1 = acc[pb][4 * g + 1] * rs * gn[1] * (g1 * sigmoidf_(g1));
                const float o2 = acc[pb][4 * g + 2] * rs * gn[2] * (g2 * sigmoidf_(g2)), o3 = acc[pb][4 * g + 3] * rs * gn[3] * (g3 * sigmoidf_(g3));
                *(LAS u32x2*)(Ol + pos * GP + dv0) = (u32x2){pk2(o0, o1), pk2(o2, o3)}; } }
        __syncthreads();
#pragma unroll
        for (int k = 0; k < 4; ++k) { const int c = tid + 512 * k, pos = c >> 5, cc = c & 31;
            *(u32x4*)(MIX + (size_t)(t0 + pos) * D + 1024 + h * 256 + cc * 8) = *(const LAS u32x4*)(Ol + pos * GP + cc * 8); }
#pragma unroll
        for (int ks = 0; ks < 8; ++ks) af[ks] = afn[ks];
        qs[0] = qsn[0]; qs[1] = qsn[1];
#pragma unroll
        for (int k = 0; k < 4; ++k) gr[k] = grn[k];
    }
#undef GO_LOAD
}

constexpr int AT_KP = 200, AT_VP = 68;
constexpr int AT_KB = 64 * AT_KP * 2, AT_VB = 128 * AT_VP * 2;
struct BgCtx { const float* wg; const float* wu; const float* wd; bf16* WGU; bf16* WD; int it, q; const float* sp; };
__device__ __forceinline__ void attn_unit(Frame& F, int b, int h, int qb, BgCtx& G) {
    const bf16* Qg = WSP(bf16, WS_QB) + (size_t)(b * NH + h) * SEQ * DQK;
    const bf16* Kg = WSP(bf16, WS_KB) + (size_t)(b * NH + h) * SEQ * DQK;
    const bf16* Vg = WSP(bf16, WS_VTB) + (size_t)(b * NH + h) * DV * SEQ;
    bf16* MIX = WSP(bf16, WS_MIX);
    PH_IDS(); const int w = wave, r = lane & 31, hh = lane >> 5;
    const int qrow = qb * 256 + 32 * w + r;
    bf16x8 qf[12];
#pragma unroll
    for (int ks = 0; ks < 12; ++ks) qf[ks] = *(const bf16x8*)(Qg + (size_t)qrow * DQK + 16 * ks + 8 * hh);
    const int ntiles = 4 * qb + 4, my_last = 4 * qb + (w >> 1);
    f32x16 oacc[4];
#pragma unroll
    for (int d = 0; d < 4; ++d)
#pragma unroll
        for (int i = 0; i < 16; ++i) oacc[d][i] = 0.f;
    float m_i = -INFINITY, l_i = 0.f;
    u32x4 kreg[3], vreg[2];
#define AT_LOAD(kt) do { _Pragma("unroll") for (int k = 0; k < 3; ++k) { const int c = tid + 512 * k, row = c / 24, cc = c % 24; kreg[k] = *(const u32x4*)(Kg + (size_t)((kt) * 64 + row) * DQK + cc * 8); } \
        _Pragma("unroll") for (int k = 0; k < 2; ++k) { const int c = tid + 512 * k, row = c >> 3, cc = c & 7; vreg[k] = *(const u32x4*)(Vg + (size_t)row * SEQ + (kt) * 64 + cc * 8); } } while (0)
#define AT_STORE(buf) do { LAS unsigned char* kb_ = F.lds + (buf) * (AT_KB + AT_VB); LAS unsigned char* vb_ = kb_ + AT_KB; \
        _Pragma("unroll") for (int k = 0; k < 3; ++k) { const int c = tid + 512 * k, row = c / 24, cc = c % 24; *(LAS u32x4*)(kb_ + row * (AT_KP * 2) + cc * 16) = kreg[k]; } \
        _Pragma("unroll") for (int k = 0; k < 2; ++k) { const int c = tid + 512 * k, row = c >> 3, cc = c & 7; LAS unsigned char* p_ = vb_ + row * (AT_VP * 2) + cc * 16; \
            *(LAS u32x2*)p_ = (u32x2){vreg[k].x, vreg[k].y}; *(LAS u32x2*)(p_ + 8) = (u32x2){vreg[k].z, vreg[k].w}; } } while (0)
    LAS unsigned short* bscr = (LAS unsigned short*)(F.lds + 2 * (AT_KB + AT_VB) + w * BG_SCR);
    AT_LOAD(0); AT_STORE(0);
    __builtin_amdgcn_s_waitcnt(0x0F70);
    __syncthreads();
    for (int kt = 0; kt < ntiles; ++kt) {
        const int cur = kt & 1;
        if (kt + 1 < ntiles) AT_LOAD(kt + 1);
        const bool bg = G.it < BG_MOE_ITEMS;
        f32x4 bt;
        if (bg) { if (G.q == 0) G.sp = bg_moe_item(G.it, G.wg, G.wu, G.wd, G.WGU, G.WD, lane).sp;
            bt = __builtin_nontemporal_load((const f32x4*)G.sp);
            G.sp += (size_t)8 * (G.it < 16 * 32 * 32 ? DE : D); }
        if (kt <= my_last) {
            const LAS unsigned char* kb = F.lds + cur * (AT_KB + AT_VB); const LAS unsigned char* vb = kb + AT_KB;
            f32x16 sacc[2];
#pragma unroll
            for (int kbk = 0; kbk < 2; ++kbk) {
#pragma unroll
                for (int i = 0; i < 16; ++i) sacc[kbk][i] = 0.f;
#pragma unroll
                for (int ks = 0; ks < 12; ++ks) { const bf16x8 af = *(const LAS bf16x8*)(kb + (32 * kbk + r) * (AT_KP * 2) + (16 * ks + 8 * hh) * 2); sacc[kbk] = MFMA32(af, qf[ks], sacc[kbk]); } }
            float mx = sacc[0][0];
#pragma unroll
            for (int i = 1; i < 16; ++i) mx = fmaxf(mx, sacc[0][i]);
#pragma unroll
            for (int i = 0; i < 16; ++i) mx = fmaxf(mx, sacc[1][i]);
            mx = fmaxf(mx, __shfl_xor(mx, 32));
            const float m_new = fmaxf(m_i, mx), alpha = fast_exp2(m_i - m_new);
            m_i = m_new;
            float ls = 0.f;
#pragma unroll
            for (int kbk = 0; kbk < 2; ++kbk)
#pragma unroll
                for (int i = 0; i < 16; ++i) { const float p = fast_exp2(sacc[kbk][i] - m_new); sacc[kbk][i] = p; ls += p; }
            l_i = l_i * alpha + ls;
#pragma unroll
            for (int d = 0; d < 4; ++d)
#pragma unroll
                for (int i = 0; i < 16; ++i) oacc[d][i] *= alpha;
            bf16x8 pf[2][2];
#pragma unroll
            for (int kbk = 0; kbk < 2; ++kbk)
#pragma unroll
                for (int s2 = 0; s2 < 2; ++s2) { u32x4 q; q.x = pk2(sacc[kbk][8 * s2], sacc[kbk][8 * s2 + 1]); q.y = pk2(sacc[kbk][8 * s2 + 2], sacc[kbk][8 * s2 + 3]);
                    q.z = pk2(sacc[kbk][8 * s2 + 4], sacc[kbk][8 * s2 + 5]); q.w = pk2(sacc[kbk][8 * s2 + 6], sacc[kbk][8 * s2 + 7]); pf[kbk][s2] = __builtin_bit_cast(bf16x8, q); }
#pragma unroll
            for (int d = 0; d < 4; ++d)
#pragma unroll
                for (int kbk = 0; kbk < 2; ++kbk)
#pragma unroll
                    for (int s2 = 0; s2 < 2; ++s2) { const int kk = 32 * kbk + 16 * s2; const LAS unsigned char* vp = vb + (32 * d + r) * (AT_VP * 2) + (kk + 4 * hh) * 2;
                        const u32x2 v0 = *(const LAS u32x2*)vp, v1 = *(const LAS u32x2*)(vp + 16);
                        const bf16x8 af = __builtin_bit_cast(bf16x8, ((u32x4){v0.x, v0.y, v1.x, v1.y}));
                        oacc[d] = MFMA32(af, pf[kbk][s2], oacc[d]); }
        }
        if (kt + 1 < ntiles) AT_STORE(cur ^ 1);
        if (bg) { BG_PUT(bt, bscr, lane, G.q);
            if (G.q == 7) { const BgItem bi = bg_moe_item(G.it, G.wg, G.wu, G.wd, G.WGU, G.WD, lane); BG_STORE(bi, bscr, lane); G.it += GRID * NWAVES; G.q = 0; } else ++G.q; }
        __syncthreads();
    }
#undef AT_LOAD
#undef AT_STORE
    const float lt = l_i + __shfl_xor(l_i, 32), inv = 1.0f / lt;
    LAS bf16* os = (LAS bf16*)(F.lds + w * (32 * 132 * 2));
#pragma unroll
    for (int d = 0; d < 4; ++d)
#pragma unroll
        for (int g = 0; g < 4; ++g) *(LAS u32x2*)(os + r * 132 + 32 * d + 8 * g + 4 * hh) = (u32x2){pk2(oacc[d][4 * g] * inv, oacc[d][4 * g + 1] * inv), pk2(oacc[d][4 * g + 2] * inv, oacc[d][4 * g + 3] * inv)};
    LDS_WAIT(); asm volatile("" ::: "memory");
#pragma unroll
    for (int ps = 0; ps < 8; ++ps) { const int row = (lane >> 4) + 4 * ps, c = lane & 15; const LAS unsigned char* sp_ = (const LAS unsigned char*)(os + row * 132 + 8 * c);
        const u32x2 lo = *(const LAS u32x2*)sp_, hi = *(const LAS u32x2*)(sp_ + 8);
        *(u32x4*)(MIX + (size_t)(b * SEQ + qb * 256 + 32 * w + row) * D + h * DV + 8 * c) = (u32x4){lo.x, lo.y, hi.x, hi.y}; }
    __syncthreads();
}
__device__ __forceinline__ void attn_phase(Frame& F, const Args& A) {
    const int bh = F.vcu >> 4, qp = F.vcu & 15;
    if (__builtin_amdgcn_readfirstlane(fresh_tid() >> 6) >= 4) __builtin_amdgcn_s_setprio(1);
    BgCtx G{(const float*)A.in[23], (const float*)A.in[24], (const float*)A.in[25], WSP(bf16, WS_WGU0), WSP(bf16, WS_WD0), 0, 0, nullptr};
    { PH_IDS(); G.it = F.vcu * NWAVES + wave; }
    attn_unit(F, bh >> 3, bh & 7, 31 - qp, G);
    attn_unit(F, bh >> 3, bh & 7, qp, G);
    __builtin_amdgcn_s_setprio(0);
    { PH_IDS(); LAS unsigned short* bscr = (LAS unsigned short*)(F.lds + 2 * (AT_KB + AT_VB) + wave * BG_SCR);
      for (; G.it < BG_MOE_ITEMS; G.it += GRID * NWAVES, G.q = 0) { const BgItem bi = bg_moe_item(G.it, G.wg, G.wu, G.wd, G.WGU, G.WD, lane);
          for (int q = G.q; q < 8; ++q) { const f32x4 bt = __builtin_nontemporal_load((const f32x4*)(bi.sp + (size_t)8 * q * bi.ldsrc)); BG_PUT(bt, bscr, lane, q); }
          BG_STORE(bi, bscr, lane); } }
}

constexpr int SG_P = 136;
__device__ __forceinline__ void sgu_phase(Frame& F, const float* ln_g, const float* ln_b, const float* b_s) {
    const bf16* U = WSP(bf16, WS_U); const bf16* VT = WSP(bf16, WS_VT1); const bf16* WSM = WSP(bf16, WS_WS); const float* wsum = WSP(float, WS_WSUM);
    const float* vsum = WSP(float, WS_VSP); const float* vsq = WSP(float, WS_VQP); bf16* MIX = WSP(bf16, WS_MIX);
    LAS float* mu = (LAS float*)(F.lds); LAS float* rs = mu + 128; LAS float* c1 = mu + 256;
    LAS bf16* Wl = (LAS bf16*)(F.lds + 2048); LAS bf16* Vl = (LAS bf16*)(F.lds + 2048 + 128 * SG_P * 2);
    LAS bf16* Xl = (LAS bf16*)(F.lds + 2048 + 2 * 128 * SG_P * 2);
    constexpr int XP = 132;
    PH_IDS(); const int w = wave, r = lane & 31, hh = lane >> 5;
    f32x4 sa, sq; u32x4 wv[4], vv[4], ur[4];
    LAS float* ps = (LAS float*)(F.lds + 2048 + 2 * 128 * SG_P * 2 + 128 * XP * 2);
#define SG_LOAD(su_) do { const int g_ = (su_) & 15, t0_ = ((su_) >> 4) * 128; \
        sa = *(const f32x4*)(vsum + (size_t)(t0_ + (tid & 127)) * 16 + 4 * (tid >> 7)); sq = *(const f32x4*)(vsq + (size_t)(t0_ + (tid & 127)) * 16 + 4 * (tid >> 7)); \
        _Pragma("unroll") for (int k = 0; k < 4; ++k) { const int chunk = tid + 512 * k, i = chunk >> 4, j0 = (chunk & 15) * 8; \
            wv[k] = *(const u32x4*)(WSM + (size_t)g_ * 16384 + i * 128 + j0); vv[k] = *(const u32x4*)(VT + (size_t)(128 * g_ + i) * T + t0_ + j0); \
            ur[k] = *(const u32x4*)(U + (size_t)(t0_ + i) * D + 128 * g_ + j0); } } while (0)
    if (F.vcu < 2048) SG_LOAD(F.vcu);
    for (int su = F.vcu; su < 2048; su += GRID) {
        const int g = su & 15, t0 = (su >> 4) * 128;
        ps[tid] = (sa[0] + sa[1]) + (sa[2] + sa[3]); ps[512 + tid] = (sq[0] + sq[1]) + (sq[2] + sq[3]);
        __syncthreads();
        if (tid < 128) { float s = 0.f, q = 0.f;
#pragma unroll
            for (int k = 0; k < 4; ++k) { s += ps[128 * k + tid]; q += ps[512 + 128 * k + tid]; }
            const float mean = s * (1.0f / 2048.0f), var = fmaxf(q * (1.0f / 2048.0f) - mean * mean, 0.f);
            mu[tid] = mean; rs[tid] = rsqrtf(var + EPS); }
        __syncthreads();
#pragma unroll
        for (int k = 0; k < 4; ++k) { const int chunk = tid + 512 * k, i = chunk >> 4, j0 = (chunk & 15) * 8;
            float wf[8] = {bflo(wv[k].x), bfhi(wv[k].x), bflo(wv[k].y), bfhi(wv[k].y), bflo(wv[k].z), bfhi(wv[k].z), bflo(wv[k].w), bfhi(wv[k].w)}; float cs = 0.f;
#pragma unroll
            for (int jj = 0; jj < 8; ++jj) { wf[jj] *= rs[j0 + jj]; cs += wf[jj] * mu[j0 + jj]; }
            *(LAS u32x4*)(Wl + i * SG_P + j0) = (u32x4){pk2(wf[0], wf[1]), pk2(wf[2], wf[3]), pk2(wf[4], wf[5]), pk2(wf[6], wf[7])};
#pragma unroll
            for (int o = 1; o < 16; o <<= 1) cs += __shfl_xor(cs, o);
            if ((lane & 15) == 0) c1[i] = cs;
            *(LAS u32x4*)(Vl + i * SG_P + j0) = vv[k];
            { LAS unsigned char* xp_ = (LAS unsigned char*)(Xl + i * XP + j0); *(LAS u32x2*)xp_ = (u32x2){ur[k].x, ur[k].y}; *(LAS u32x2*)(xp_ + 8) = (u32x2){ur[k].z, ur[k].w}; } }
        __syncthreads();
        if (su + GRID < 2048) SG_LOAD(su + GRID);
        const int mb = w & 3; u32x2 uu[2][4];
#pragma unroll
        for (int nb = 0; nb < 2; ++nb)
#pragma unroll
            for (int q = 0; q < 4; ++q) uu[nb][q] = *(const LAS u32x2*)(Xl + (32 * (2 * (w >> 2) + nb) + r) * XP + 32 * mb + 8 * q + 4 * hh);
        f32x16 acc[2];
#pragma unroll
        for (int nb = 0; nb < 2; ++nb)
#pragma unroll
            for (int i = 0; i < 16; ++i) acc[nb][i] = 0.f;
        { bf16x8 afr[8], bfr[8];
#pragma unroll
          for (int ks = 0; ks < 8; ++ks) afr[ks] = *(const LAS bf16x8*)(Vl + (32 * mb + r) * SG_P + 16 * ks + 8 * hh);
#pragma unroll
          for (int nb = 0; nb < 2; ++nb) {
#pragma unroll
              for (int ks = 0; ks < 8; ++ks) bfr[ks] = *(const LAS bf16x8*)(Wl + (32 * (2 * (w >> 2) + nb) + r) * SG_P + 16 * ks + 8 * hh);
              __builtin_amdgcn_sched_barrier(0);
#pragma unroll
              for (int ks = 0; ks < 8; ++ks) acc[nb] = MFMA32(afr[ks], bfr[ks], acc[nb]);
              __builtin_amdgcn_sched_barrier(0); } }
        __syncthreads();
#pragma unroll
        for (int nb = 0; nb < 2; ++nb) { const int i = 32 * (2 * (w >> 2) + nb) + r;
            const float c1i = c1[i], wsi = wsum[g * 128 + i], bsi = b_s[g * 128 + i];
#pragma unroll
            for (int q = 0; q < 4; ++q) { const int ch = 128 * g + 32 * mb + 8 * q + 4 * hh;
                const f32x4 lg = *(const f32x4*)(ln_g + ch), lb = *(const f32x4*)(ln_b + ch); const u32x2 u2 = uu[nb][q];
                const float o0 = bflo(u2.x) * (lg[0] * (acc[nb][4 * q] - c1i) + lb[0] * wsi + bsi), o1 = bfhi(u2.x) * (lg[1] * (acc[nb][4 * q + 1] - c1i) + lb[1] * wsi + bsi);
                const float o2 = bflo(u2.y) * (lg[2] * (acc[nb][4 * q + 2] - c1i) + lb[2] * wsi + bsi), o3 = bfhi(u2.y) * (lg[3] * (acc[nb][4 * q + 3] - c1i) + lb[3] * wsi + bsi);
                *(LAS u32x2*)(Xl + i * XP + 32 * mb + 8 * q + 4 * hh) = (u32x2){pk2(o0, o1), pk2(o2, o3)}; } }
        __syncthreads();
#pragma unroll
        for (int ps = 0; ps < 4; ++ps) { const int row = (tid >> 4) + 32 * ps, c = tid & 15; const LAS unsigned char* xp_ = (const LAS unsigned char*)(Xl + row * XP + 8 * c);
            const u32x2 lo = *(const LAS u32x2*)xp_, hi = *(const LAS u32x2*)(xp_ + 8);
            *(u32x4*)(MIX + (size_t)(t0 + row) * D + 128 * g + 8 * c) = (u32x4){lo.x, lo.y, hi.x, hi.y}; }
    }
#undef SG_LOAD
}

__device__ __forceinline__ float wave_sum16(float v) { return wave_sum(v); }
__device__ __forceinline__ void ln_route_phase(Frame& F, const float* lng, const float* lnb, const float* router_w, const float* router_b, int layer) {
    const bf16* PRE = WSP(bf16, WS_PRE); bf16* X1 = WSP(bf16, WS_X1); int* LIST = WSP(int, WS_LIST); unsigned* REC = WSP(unsigned, WS_REC);
    unsigned* gcnt = (unsigned*)(F.ctl + CW_CNT + layer * 16 * 64);
    LAS float* rw = (LAS float*)(F.lds);
    LAS float* LG = (LAS float*)(F.lds + MISC_OFF) + 1024;
    volatile LAS unsigned* M = F.MISC;
    PH_IDS(); const int w = wave;
#pragma unroll
    for (int hb = 0; hb < 2; ++hb) { f32x4 t[8];
#pragma unroll
        for (int k = 0; k < 8; ++k) t[k] = *(const f32x4*)(router_w + 4 * (size_t)(tid + 512 * (8 * hb + k)));
        asm volatile("" ::: "memory");
#pragma unroll
        for (int k = 0; k < 8; ++k) { const int c = tid + 512 * (8 * hb + k), d = c >> 2, e0 = 4 * (c & 3);
#pragma unroll
            for (int i = 0; i < 4; ++i) rw[(e0 + i) * D + (d ^ (4 * (e0 + i)))] = t[k][i]; } }
    if (tid < 16) M[MW_LCNT + tid] = 0u;
    __syncthreads();
    float rb[16];
#pragma unroll
    for (int e = 0; e < 16; ++e) rb[e] = router_b[e];
    u32x2 prow[2][8];
#define LN1_LOAD(k, pb) do { const u32x2* pr_ = (const u32x2*)(PRE + (size_t)(F.vcu * 64 + w * 8 + (k)) * D) + lane; _Pragma("unroll") for (int j = 0; j < 8; ++j) prow[pb][j] = pr_[64 * j]; } while (0)
#define LN1_BODY(k, PB) do { \
        const int lt = w * 8 + k, tok = F.vcu * 64 + lt; \
        if (k + 1 < 8) LN1_LOAD(k + 1, 1 - PB); \
        f32x4 gg[8], gb[8];        \
_Pragma("unroll") \
        for (int j = 0; j < 8; ++j) { gg[j] = *((const f32x4*)lng + lane + 64 * j); gb[j] = *((const f32x4*)lnb + lane + 64 * j); } \
        asm volatile("" ::: "memory"); \
        f32x4 v[8]; float s = 0.f; \
_Pragma("unroll") \
        for (int j = 0; j < 8; ++j) { const u32x2 pq = prow[PB][j]; v[j] = (f32x4){bflo(pq.x), bfhi(pq.x), bflo(pq.y), bfhi(pq.y)}; \
            s += (v[j][0] + v[j][1]) + (v[j][2] + v[j][3]); } \
        const float mean = wave_sum(s) * (1.0f / D); float s2 = 0.f; \
_Pragma("unroll") \
        for (int j = 0; j < 8; ++j) { v[j] = v[j] - mean; s2 += (v[j][0] * v[j][0] + v[j][1] * v[j][1]) + (v[j][2] * v[j][2] + v[j][3] * v[j][3]); } \
        const float rstd = rsqrtf(wave_sum(s2) * (1.0f / D) + EPS); \
        u32x2* xo = (u32x2*)(X1 + (size_t)tok * D) + lane; \
_Pragma("unroll") \
        for (int j = 0; j < 8; ++j) { v[j] = v[j] * rstd * gg[j] + gb[j]; \
            xo[64 * j] = (u32x2){pk2(v[j][0], v[j][1]), pk2(v[j][2], v[j][3])}; } \
        float pt[16]; \
_Pragma("unroll") \
        for (int e = 0; e < 16; ++e) { f32x2 a2 = {0.f, 0.f}; f32x4 q[8];        \
_Pragma("unroll") \
            for (int j = 0; j < 8; ++j) q[j] = *(const LAS f32x4*)(rw + e * D + 256 * j + ((4 * lane) ^ (4 * e))); \
            __builtin_amdgcn_sched_barrier(0);        \
_Pragma("unroll") \
            for (int j = 0; j < 8; ++j) { a2 += (f32x2){v[j][0], v[j][1]} * (f32x2){q[j][0], q[j][1]}; a2 += (f32x2){v[j][2], v[j][3]} * (f32x2){q[j][2], q[j][3]}; } \
            pt[e] = a2[0] + a2[1]; } \
        {   \
          const bool b5 = (lane & 32) != 0, b4 = (lane & 16) != 0, b3 = (lane & 8) != 0, b2 = (lane & 4) != 0; float p8[8], p4[4], p2[2], p1; \
          _Pragma("unroll") for (int i = 0; i < 8; ++i) p8[i] = (b5 ? pt[i + 8] : pt[i]) + __shfl_xor(b5 ? pt[i] : pt[i + 8], 32); \
          _Pragma("unroll") for (int i = 0; i < 4; ++i) p4[i] = (b4 ? p8[i + 4] : p8[i]) + __shfl_xor(b4 ? p8[i] : p8[i + 4], 16); \
          _Pragma("unroll") for (int i = 0; i < 2; ++i) p2[i] = (b3 ? p4[i + 2] : p4[i]) + __shfl_xor(b3 ? p4[i] : p4[i + 2], 8); \
          p1 = (b2 ? p2[1] : p2[0]) + __shfl_xor(b2 ? p2[0] : p2[1], 4); p1 += __shfl_xor(p1, 2); p1 += __shfl_xor(p1, 1); \
            \
          if ((lane & 3) == 0) LG[lt * 16 + 8 * (lane >> 5) + 4 * ((lane >> 4) & 1) + 2 * ((lane >> 3) & 1) + ((lane >> 2) & 1)] = p1; } \
    } while (0)
    LN1_LOAD(0, 0);
    for (int kk = 0; kk < 8; kk += 2) { { const int k = kk; LN1_BODY(k, 0); } { const int k = kk + 1; LN1_BODY(k, 1); } }
#undef LN1_BODY
#undef LN1_LOAD
    LDS_WAIT(); asm volatile("" ::: "memory");
    if (lane < 8) { const int lt = w * 8 + lane; float lg[16];
#pragma unroll
        for (int q4 = 0; q4 < 4; ++q4) { const f32x4 t4 = *(const LAS f32x4*)(LG + lt * 16 + 4 * q4); lg[4 * q4] = t4[0]; lg[4 * q4 + 1] = t4[1]; lg[4 * q4 + 2] = t4[2]; lg[4 * q4 + 3] = t4[3]; }
        float sc[16], bs[16];
#pragma unroll
        for (int e = 0; e < 16; ++e) { sc[e] = 1.0f / (1.0f + __expf(-lg[e])); bs[e] = sc[e] + rb[e]; }
        float gs[4];
#pragma unroll
        for (int g = 0; g < 4; ++g) { const float a0 = bs[4 * g], a1 = bs[4 * g + 1], a2 = bs[4 * g + 2], a3 = bs[4 * g + 3];
            const float h01 = fmaxf(a0, a1), l01 = fminf(a0, a1), h23 = fmaxf(a2, a3), l23 = fminf(a2, a3);
            const float t1 = fmaxf(h01, h23), t2 = fmaxf(fminf(h01, h23), (h01 >= h23) ? l01 : l23); gs[g] = t1 + t2; }
        int best = 0; float bv = gs[0];
#pragma unroll
        for (int g = 1; g < 4; ++g) if (gs[g] > bv) { bv = gs[g]; best = g; }
        float cb[4], cs[4];
#pragma unroll
        for (int i = 0; i < 4; ++i) { cb[i] = best == 0 ? bs[i] : best == 1 ? bs[4 + i] : best == 2 ? bs[8 + i] : bs[12 + i]; cs[i] = best == 0 ? sc[i] : best == 1 ? sc[4 + i] : best == 2 ? sc[8 + i] : sc[12 + i]; }
        int i0 = 0; float v0 = cb[0];
#pragma unroll
        for (int i = 1; i < 4; ++i) if (cb[i] > v0) { v0 = cb[i]; i0 = i; }
        int i1 = -1; float v1 = -INFINITY;
#pragma unroll
        for (int i = 0; i < 4; ++i) if (i != i0 && cb[i] > v1) { v1 = cb[i]; i1 = i; }
        const float s0 = i0 == 0 ? cs[0] : i0 == 1 ? cs[1] : i0 == 2 ? cs[2] : cs[3], s1 = i1 == 0 ? cs[0] : i1 == 1 ? cs[1] : i1 == 2 ? cs[2] : cs[3];
        const float g0 = s0 / (s0 + s1), g1 = s1 / (s0 + s1);
        const int e0 = 4 * best + i0, e1 = 4 * best + i1;
        const unsigned p0 = __hip_atomic_fetch_add((LAS unsigned*)(M + MW_LCNT + e0), 1u, __ATOMIC_RELAXED, __HIP_MEMORY_SCOPE_WORKGROUP), p1 = __hip_atomic_fetch_add((LAS unsigned*)(M + MW_LCNT + e1), 1u, __ATOMIC_RELAXED, __HIP_MEMORY_SCOPE_WORKGROUP);
        M[MW_REC + lt * 8 + 0] = (unsigned)e0; M[MW_REC + lt * 8 + 1] = (unsigned)e1; M[MW_REC + lt * 8 + 2] = p0; M[MW_REC + lt * 8 + 3] = p1;
        M[MW_REC + lt * 8 + 4] = __builtin_bit_cast(unsigned, g0); M[MW_REC + lt * 8 + 5] = __builtin_bit_cast(unsigned, g1); }
    __syncthreads();
    if (tid < 16) M[MW_LBASE + tid] = __hip_atomic_fetch_add(gcnt + tid * 64, M[MW_LCNT + tid], RLX_AGENT);
    __syncthreads();
    if (tid < 64) { const int tok = F.vcu * 64 + tid; const unsigned e0 = M[MW_REC + tid * 8], e1 = M[MW_REC + tid * 8 + 1];
        const unsigned p0 = M[MW_LBASE + e0] + M[MW_REC + tid * 8 + 2], p1 = M[MW_LBASE + e1] + M[MW_REC + tid * 8 + 3];
        LIST[e0 * T + p0] = tok; LIST[e1 * T + p1] = tok;
        *(u32x4*)(REC + (size_t)tok * 8) = (u32x4){e0, e1, p0, p1}; *(u32x2*)(REC + (size_t)tok * 8 + 4) = (u32x2){M[MW_REC + tid * 8 + 4], M[MW_REC + tid * 8 + 5]}; }
    __syncthreads();
}

__device__ __forceinline__ void moe_tables(Frame& F, int layer) {
    if (threadIdx.x == 0) { unsigned acc = 0;
        for (int e = 0; e < 16; ++e) { const unsigned c = __hip_atomic_load((unsigned*)(F.ctl + CW_CNT + (layer * 16 + e) * 64), RLX_AGENT); F.MISC[MW_CNT + e] = c; F.MISC[MW_TP + e] = acc; acc += (c + 255u) >> 8; }
        F.MISC[MW_TP + 16] = acc; }
    __syncthreads();
}
template <bool UP> struct MoeOrder {
    volatile LAS unsigned* M; const int* LIST; const char* A; const char* W; int G, c, nN; int e_lo = 0, e_hi = 16, nHead = 0, K = 0;
    __device__ __forceinline__ bool next(int i, pg8::Unit& u) const {
        const int base = (int)M[MW_TP + e_lo] * nN, total = (int)M[MW_TP + e_hi] * nN - base; const int nb = G - nHead;
        const long L = (nHead == 0) ? (long)i * G + c : (c >= nHead ? (i < K ? (long)i * nb + (c - nHead) : (long)K * nb + (long)(i - K) * G + c) : (long)K * nb + (long)i * G + c);
        if (L >= total) return false;
        int wgid = (int)L; { const int q = total / 8, r = total % 8, xcd = wgid % 8, off = wgid / 8; wgid = (xcd < r ? xcd * (q + 1) : r * (q + 1) + (xcd - r) * q) + off; }
        wgid += base;
        int e = 0;
#pragma unroll
        for (int k = 1; k < 16; ++k) if (wgid >= (int)M[MW_TP + k] * nN) e = k;
        const int tp = (int)M[MW_TP + e], nmt = (int)M[MW_TP + e + 1] - tp, idx = wgid - tp * nN;
        u.pm = idx % nmt; u.pn = idx / nmt; u.aux = e; u.aux2 = 256 * (tp + u.pm);
        if (UP) { u.a = A; u.b = W + ((size_t)e * 1024 + (size_t)u.pn * 256) * D * 2; }
        else { u.a = A + (size_t)u.aux2 * DE * 2; u.b = W + ((size_t)e * D + (size_t)u.pn * 256) * DE * 2; }
        return true; }
    __device__ __forceinline__ unsigned row_off(const pg8::Unit& u, int r) const {
        const int m = u.pm * 256 + r; const int tok = (m < (int)M[MW_CNT + u.aux]) ? LIST[u.aux * T + m] : 0; return (unsigned)tok * (unsigned)(D * 2); }
};

template <bool FINAL> __device__ __forceinline__ void ln_ffn_phase(Frame& F, const float* lng, const float* lnb, float* out) {
    const bf16* X1 = WSP(bf16, WS_X1); const bf16* YS = WSP(bf16, WS_YS); const unsigned* REC = WSP(unsigned, WS_REC); bf16* XB = WSP(bf16, WS_XB);
    PH_IDS(); const int w = wave; const int tok0 = F.vcu * 64 + w * 8;
    LAS unsigned* RT = (LAS unsigned*)(F.lds);
    if (tid < 64) { const unsigned* rc = REC + (size_t)(F.vcu * 64 + tid) * 8; const unsigned e0 = rc[0], e1 = rc[1], p0 = rc[2], p1 = rc[3];
        RT[tid * 4 + 0] = F.MISC[MW_TP + e0] * 256u + p0; RT[tid * 4 + 1] = F.MISC[MW_TP + e1] * 256u + p1; RT[tid * 4 + 2] = rc[4]; RT[tid * 4 + 3] = rc[5]; }
    __syncthreads();
    u32x4 ra[3][4], rp[3][4], rq[3][4];
#define LN2_LOAD(k, pb) do { const u32x4* xp_ = (const u32x4*)(X1 + (size_t)(tok0 + (k)) * D) + lane; const u32x4* y0_ = (const u32x4*)(YS + (size_t)RT[(w * 8 + (k)) * 4] * D) + lane; const u32x4* y1_ = (const u32x4*)(YS + (size_t)RT[(w * 8 + (k)) * 4 + 1] * D) + lane; \
        _Pragma("unroll") for (int j = 0; j < 4; ++j) { ra[pb][j] = xp_[64 * j]; rp[pb][j] = y0_[64 * j]; rq[pb][j] = y1_[64 * j]; } } while (0)
#define LN2_MIX(a_, p_, q_) (f32x4){ALPHA * bflo(a_.x) + ga * bflo(p_.x) + gb * bflo(q_.x), ALPHA * bfhi(a_.x) + ga * bfhi(p_.x) + gb * bfhi(q_.x), ALPHA * bflo(a_.y) + ga * bflo(p_.y) + gb * bflo(q_.y), ALPHA * bfhi(a_.y) + ga * bfhi(p_.y) + gb * bfhi(q_.y)}
#define LN2_BODY(k, PB) do { \
        const int tok = tok0 + (k); \
        if ((k) + 2 < 8) LN2_LOAD((k) + 2, ((k) + 2) % 3); \
        f32x4 v[8]; float s = 0.f; const float ga = __builtin_bit_cast(float, RT[(w * 8 + (k)) * 4 + 2]), gb = __builtin_bit_cast(float, RT[(w * 8 + (k)) * 4 + 3]); \
        _Pragma("unroll") for (int j = 0; j < 4; ++j) { const u32x4 a = ra[PB][j], p = rp[PB][j], q = rq[PB][j]; \
            const u32x2 a0 = {a.x, a.y}, a1 = {a.z, a.w}, p0 = {p.x, p.y}, p1 = {p.z, p.w}, q0 = {q.x, q.y}, q1 = {q.z, q.w}; \
            v[2 * j] = LN2_MIX(a0, p0, q0); v[2 * j + 1] = LN2_MIX(a1, p1, q1); \
            s += ((v[2 * j][0] + v[2 * j][1]) + (v[2 * j][2] + v[2 * j][3])) + ((v[2 * j + 1][0] + v[2 * j + 1][1]) + (v[2 * j + 1][2] + v[2 * j + 1][3])); } \
        const float mean = wave_sum(s) * (1.0f / D); float s2 = 0.f; \
        _Pragma("unroll") for (int j = 0; j < 8; ++j) { v[j] = v[j] - mean; s2 += (v[j][0] * v[j][0] + v[j][1] * v[j][1]) + (v[j][2] * v[j][2] + v[j][3] * v[j][3]); } \
        const float rstd = rsqrtf(wave_sum(s2) * (1.0f / D) + EPS); \
        _Pragma("unroll") for (int j = 0; j < 4; ++j) { const f32x4* gp = (const f32x4*)lng + 2 * (lane + 64 * j); const f32x4* bp = (const f32x4*)lnb + 2 * (lane + 64 * j); \
            v[2 * j] = v[2 * j] * rstd * gp[0] + bp[0]; v[2 * j + 1] = v[2 * j + 1] * rstd * gp[1] + bp[1]; \
            if (FINAL) { f32x4* op = (f32x4*)(out + (size_t)tok * D) + 2 * (lane + 64 * j); op[0] = v[2 * j]; op[1] = v[2 * j + 1]; } \
            else *((u32x4*)(XB + (size_t)tok * D) + lane + 64 * j) = pack8(v[2 * j], v[2 * j + 1]); } } while (0)
    LN2_LOAD(0, 0); LN2_LOAD(1, 1);
    LN2_BODY(0, 0); __builtin_amdgcn_sched_barrier(0); LN2_BODY(1, 1); __builtin_amdgcn_sched_barrier(0); LN2_BODY(2, 2); __builtin_amdgcn_sched_barrier(0); LN2_BODY(3, 0); __builtin_amdgcn_sched_barrier(0);
    LN2_BODY(4, 1); __builtin_amdgcn_sched_barrier(0); LN2_BODY(5, 2); __builtin_amdgcn_sched_barrier(0); LN2_BODY(6, 0); __builtin_amdgcn_sched_barrier(0); LN2_BODY(7, 1);
#undef LN2_BODY
#undef LN2_MIX
#undef LN2_LOAD
    __syncthreads();
}


__global__ void __launch_bounds__(NTHR, 2) fwd_kernel(Args args) {
    extern __shared__ __attribute__((aligned(16))) unsigned char lds_raw[];
    Frame F;
    F.lds = (LAS unsigned char*)lds_raw; F.MISC = (volatile LAS unsigned*)(F.lds + MISC_OFF);
    { const int bx = blockIdx.x; F.vcu = (bx % 8) * (GRID / 8) + bx / 8; }
    F.ws = args.ws; F.ctl = (gu32*)(args.ws + WS_CTL);
    for (int u = threadIdx.x; u < (LDS_BYTES - MISC_OFF) / 4; u += NTHR) F.MISC[u] = 0u;
    __syncthreads();
    XcdBarrier bar = xcd_barrier_post((unsigned*)(F.ctl + CW_BAR), F.MISC + MW_BAR);
#define GRID_BAR() xcd_barrier(bar)
    LAS unsigned char* ring = F.lds;
    const int bx = (int)blockIdx.x;
    float* rsq = WSP(float, WS_RSQP); float* rskv = WSP(float, WS_RSKVP);

    p0_prologue(F, args);
    GRID_BAR();

    { pg8::PlainOrder S; S.init(WSP(bf16, WS_XB), WSP(bf16, WS_WIN0), T, 4096, D, D, GRID, bx);
      EpiIn0 E{WSP(bf16, WS_HB), rsq, rskv};
      pg8::gemm_phase<EpiIn0, pg8::PlainOrder, false>(ring, D, D, D, S, E);
    }
    { pg8::PlainOrder S; S.init(WSP(bf16, WS_XB), WSP(bf16, WS_WX0), T, 256, D, D, GRID, bx, 4, 512);
      EpiExtra E{WSP(float, WS_EXTRA)};
      pg8::gemm_phase<EpiExtra, pg8::PlainOrder, false>(ring, 512, D, D, S, E); }
    GRID_BAR();
    { pg8::PlainOrder S; S.init(WSP(bf16, WS_HB) + COL_CQ, WSP(bf16, WS_WUQ), T, 1536, HBW, 512, GRID, bx);
      EpiQ E{WSP(bf16, WS_QB), rsq, WSP(float, WS_COS), WSP(float, WS_SIN)};
      pg8::gemm_phase<EpiQ, pg8::PlainOrder, false>(ring, 512, HBW, 512, S, E); }
    { pg8::PlainOrder S; S.init(WSP(bf16, WS_HB) + COL_CKV, WSP(bf16, WS_WUK), T, 1024, HBW, 512, GRID, bx);
      EpiK E{WSP(bf16, WS_KB), rskv};
      pg8::gemm_phase<EpiK, pg8::PlainOrder, false>(ring, 512, HBW, 512, S, E); }
    { pg8::PlainOrder S; S.init(WSP(bf16, WS_WUV), WSP(bf16, WS_HB) + COL_CKV, 1024, T, 512, HBW, GRID, bx);
      EpiVt E{WSP(bf16, WS_VTB), rskv};
      pg8::gemm_phase<EpiVt, pg8::PlainOrder, false>(ring, 512, 512, HBW, S, E); }
    gla_upd_phase(F, (const float*)args.in[7], (const float*)args.in[8]);
    krot_phase(F);
    GRID_BAR();
    attn_phase(F, args);
    gla_scan_phase(F);
    GRID_BAR();
    gla_out_phase(F, (const float*)args.in[9]);
    GRID_BAR();
    { pg8::PlainOrder S; S.init(WSP(bf16, WS_MIX), WSP(bf16, WS_WO0), T, D, D, D, GRID, bx);
      EpiPre<false> E{WSP(bf16, WS_PRE), (const float*)args.in[0], nullptr};
      pg8::gemm_phase<EpiPre<false>, pg8::PlainOrder, false>(ring, D, D, D, S, E); }
    GRID_BAR();
    ln_route_phase(F, (const float*)args.in[17], (const float*)args.in[18], (const float*)args.in[21], (const float*)args.in[22], 0);
    GRID_BAR();
    moe_tables(F, 0);
    { MoeOrder<true> S{F.MISC, WSP(int, WS_LIST), (const char*)WSP(bf16, WS_X1), (const char*)WSP(bf16, WS_WGU0), GRID, bx, 4};
      EpiMoeUp E{WSP(bf16, WS_HM)};
      pg8::gemm_phase<EpiMoeUp, MoeOrder<true>, true>(ring, D, D, D, S, E); }
    { const int rem = ((int)F.MISC[MW_TP + 16] * 4) % GRID; const int first = (rem > 0 && rem <= GRID / 2) ? rem : 0;
      if (bx >= first) cvt_moe_layer(F, (const float*)args.in[23] + (size_t)NE * D * DE, (const float*)args.in[24] + (size_t)NE * D * DE, (const float*)args.in[25] + (size_t)NE * D * DE,
                  WSP(bf16, WS_WGU1), WSP(bf16, WS_WD1), first, 0, MOE_CVT_SPLIT); }
    GRID_BAR();
    { MoeOrder<false> S{F.MISC, WSP(int, WS_LIST), (const char*)WSP(bf16, WS_HM), (const char*)WSP(bf16, WS_WD0), GRID, bx, 8};
      EpiMoeDown E{WSP(bf16, WS_YS)};
      pg8::gemm_phase<EpiMoeDown, MoeOrder<false>, false>(ring, DE, DE, DE, S, E); }
    { const int rem = ((int)F.MISC[MW_TP + 16] * 8) % GRID; const int first = (rem > 0 && rem <= GRID / 2) ? rem : 0;
      if (bx >= first) cvt_moe_layer(F, (const float*)args.in[23] + (size_t)NE * D * DE, (const float*)args.in[24] + (size_t)NE * D * DE, (const float*)args.in[25] + (size_t)NE * D * DE,
                  WSP(bf16, WS_WGU1), WSP(bf16, WS_WD1), first, MOE_CVT_SPLIT, 16 * 32 * 32 + 16 * 8 * 64); }
    GRID_BAR();
    ln_ffn_phase<false>(F, (const float*)args.in[19], (const float*)args.in[20], nullptr);
    GRID_BAR();

    { pg8::PlainOrder S; S.init(WSP(bf16, WS_XB), WSP(bf16, WS_WIN1), T, D, D, D, GRID, bx);
      EpiU E{WSP(bf16, WS_U)};
      pg8::gemm_phase<EpiU, pg8::PlainOrder, false>(ring, D, D, D, S, E); }
    { pg8::PlainOrder S; S.init(WSP(bf16, WS_WIN1) + (size_t)D * D, WSP(bf16, WS_XB), D, T, D, D, GRID, bx);
      EpiVT1 E{WSP(bf16, WS_VT1), WSP(float, WS_VSP), WSP(float, WS_VQP)};
      pg8::gemm_phase<EpiVT1, pg8::PlainOrder, false>(ring, D, D, D, S, E); }
    GRID_BAR();
    sgu_phase(F, (const float*)args.in[12], (const float*)args.in[13], (const float*)args.in[15]);
    GRID_BAR();
    { pg8::PlainOrder S; S.init(WSP(bf16, WS_MIX), WSP(bf16, WS_WO1), T, D, D, D, GRID, bx);
      EpiPre<true> E{WSP(bf16, WS_PRE), nullptr, WSP(bf16, WS_XB)};
      pg8::gemm_phase<EpiPre<true>, pg8::PlainOrder, false>(ring, D, D, D, S, E); }
    GRID_BAR();
    ln_route_phase(F, (const float*)args.in[17] + D, (const float*)args.in[18] + D, (const float*)args.in[21], (const float*)args.in[22], 1);
    GRID_BAR();
    moe_tables(F, 1);
    int E1 = 0, nHead = 0;
    { const int full = ((int)F.MISC[MW_TP + 16] * 4 / GRID) * GRID;
#pragma unroll
      for (int e = 1; e <= 16; ++e) if ((int)F.MISC[MW_TP + e] * 4 <= full) E1 = e;
      const int nUp = ((int)F.MISC[MW_TP + 16] - (int)F.MISC[MW_TP + E1]) * 4; nHead = (nUp + 7) & ~7; if (nHead > GRID) nHead = GRID; }
    { MoeOrder<true> S{F.MISC, WSP(int, WS_LIST), (const char*)WSP(bf16, WS_X1), (const char*)WSP(bf16, WS_WGU1), GRID, bx, 4, 0, E1};
      EpiMoeUp E{WSP(bf16, WS_HM)};
      pg8::gemm_phase<EpiMoeUp, MoeOrder<true>, true>(ring, D, D, D, S, E); }
    GRID_BAR();
    { MoeOrder<true> S{F.MISC, WSP(int, WS_LIST), (const char*)WSP(bf16, WS_X1), (const char*)WSP(bf16, WS_WGU1), GRID, bx, 4, E1, 16};
      EpiMoeUp E{WSP(bf16, WS_HM)};
      pg8::gemm_phase<EpiMoeUp, MoeOrder<true>, true>(ring, D, D, D, S, E); }
    { MoeOrder<false> S{F.MISC, WSP(int, WS_LIST), (const char*)WSP(bf16, WS_HM), (const char*)WSP(bf16, WS_WD1), GRID, bx, 8, 0, E1, nHead, 4};
      EpiMoeDown E{WSP(bf16, WS_YS)};
      pg8::gemm_phase<EpiMoeDown, MoeOrder<false>, false>(ring, DE, DE, DE, S, E); }
    GRID_BAR();
    { MoeOrder<false> S{F.MISC, WSP(int, WS_LIST), (const char*)WSP(bf16, WS_HM), (const char*)WSP(bf16, WS_WD1), GRID, bx, 8, E1, 16};
      EpiMoeDown E{WSP(bf16, WS_YS)};
      pg8::gemm_phase<EpiMoeDown, MoeOrder<false>, false>(ring, DE, DE, DE, S, E); }
    GRID_BAR();
    ln_ffn_phase<true>(F, (const float*)args.in[19] + D, (const float*)args.in[20] + D, args.out);
}

extern "C" void kernel_launch(void* const* d_in, const int* in_sizes, int n_in, void* d_out, int out_size, void* d_ws, size_t ws_size, hipStream_t stream) {
    static int ready = 0;
    if (ready == 0) {
        if (n_in != 26 || in_sizes[0] != T * D || out_size != T * D || ws_size < WS_END) { fprintf(stderr, "kernel_launch: unexpected shapes (n_in %d, in0 %d, out %d, ws %zu < %zu)\n", n_in, n_in > 0 ? in_sizes[0] : -1, out_size, ws_size, (size_t)WS_END); ready = -1; return; }
        if (hipFuncSetAttribute((const void*)fwd_kernel, hipFuncAttributeMaxDynamicSharedMemorySize, LDS_BYTES) != hipSuccess) { fprintf(stderr, "kernel_launch: hipFuncSetAttribute failed\n"); ready = -1; return; }
        int per_cu = 0, dev = 0, cus = 0;
        (void)hipGetDevice(&dev); (void)hipDeviceGetAttribute(&cus, hipDeviceAttributeMultiprocessorCount, dev);
        if (hipOccupancyMaxActiveBlocksPerMultiprocessor(&per_cu, (const void*)fwd_kernel, NTHR, LDS_BYTES) != hipSuccess || per_cu < 1 || cus < GRID) {
            fprintf(stderr, "kernel_launch: occupancy query reports %d blocks per CU on %d CUs; the kernel needs %d resident workgroups\n", per_cu, cus, GRID); }
        (void)hipGetLastError();
        ready = 1;
    }
    if (ready < 0) return;
    if (hipMemsetAsync((char*)d_ws + WS_CTL, 0, CTL_ZERO_BYTES, stream) != hipSuccess) { fprintf(stderr, "kernel_launch: hipMemsetAsync failed\n"); return; }
    Args a{};
    for (int i = 0; i < 26; ++i) a.in[i] = d_in[i];
    a.out = (float*)d_out; a.ws = (unsigned char*)d_ws;
    hipLaunchKernelGGL(fwd_kernel, dim3(GRID), dim3(NTHR), LDS_BYTES, stream, a);
}
```
